# Optimizing an MI355X kernel written in HIP

```python
import jax, jax.numpy as jnp
from jax import lax
import numpy as np

D_MODEL = 1024
BATCH = 8
SEQ = 4096
DEPTH = 2

GRID_W = 64
CTX_LEN = 256
HEAD_DIM = 64
N_FREQ = HEAD_DIM // 4
RET_HEADS = 4
SWA_Q_HEADS = 8
SWA_KV_HEADS = 2
GDN_HEADS = 4
RET_W = RET_HEADS * HEAD_DIM
SWA_W = SWA_Q_HEADS * HEAD_DIM
SWA_KV_W = SWA_KV_HEADS * HEAD_DIM
GDN_W = GDN_HEADS * HEAD_DIM
MIX_W = RET_W + SWA_W + GDN_W
IN_W = 4 * RET_W + SWA_W + 2 * SWA_KV_W + 4 * GDN_W + 4 * GDN_HEADS
WINDOW = 128
Q_BLOCK = 128
RET_CHUNK = 64
GDN_CHUNK = 64
CONV_W = 3
D_FF = ((8 * D_MODEL + 3 * 256 - 1) // (3 * 256)) * 256
ROPE_BASE = 10000.0
EPS = 1e-6
NEG_INF = -1e30
N_MOD = 6

kernel_name = 'hybrid_parallel_heads_dit_block'


def rmsnorm(x, w):
    xf = x.astype(jnp.float32)
    y = xf * lax.rsqrt(jnp.mean(xf * xf, axis=-1, keepdims=True) + EPS)
    return (y * w.astype(jnp.float32)).astype(x.dtype)


def head_rms(o):
    return o * lax.rsqrt(jnp.mean(o * o, axis=-1, keepdims=True) + EPS)


def l2norm(t):
    return t * lax.rsqrt(jnp.sum(t * t, axis=-1, keepdims=True) + EPS)


def flip(t):
    return jnp.flip(t, axis=2)


def heads(t, h):
    b, l, _ = t.shape
    return t.reshape(b, l, h, HEAD_DIM).transpose(0, 2, 1, 3)


def merge(t):
    b, h, l, d = t.shape
    return t.transpose(0, 2, 1, 3).reshape(b, l, h * d)


def axial_rope(rows):
    row = jnp.repeat(jnp.arange(rows), GRID_W).astype(jnp.float32)
    col = jnp.tile(jnp.arange(GRID_W), rows).astype(jnp.float32)
    freqs = ROPE_BASE ** (-jnp.arange(N_FREQ, dtype=jnp.float32) / N_FREQ)
    ang = jnp.stack([row[:, None] * freqs, col[:, None] * freqs], axis=1)
    return jnp.cos(ang), jnp.sin(ang)


def apply_rope(t, cos, sin):
    tr = t.reshape(*t.shape[:-1], 2, 2, N_FREQ).astype(jnp.float32)
    t1, t2 = tr[..., 0, :], tr[..., 1, :]
    out = jnp.stack([t1 * cos - t2 * sin, t1 * sin + t2 * cos], axis=-2)
    return out.reshape(t.shape).astype(t.dtype)


def split_proj(p):
    sizes = (RET_W, RET_W, RET_W, RET_W,
             SWA_W, SWA_KV_W, SWA_KV_W,
             GDN_W, GDN_W, GDN_W, GDN_W, 2 * GDN_HEADS, 2 * GDN_HEADS)
    out, start = [], 0
    for s in sizes:
        out.append(p[..., start:start + s])
        start += s
    return out


def short_conv(t, w):
    l = t.shape[1]
    pad = CONV_W // 2
    tp = jnp.pad(t, ((0, 0), (pad, pad), (0, 0)))
    return sum(tp[:, j:j + l] * w[j] for j in range(CONV_W))


def retention_chunked(q, k, v, log_gamma, s0):
    b, h, l, dk = q.shape
    dv = v.shape[-1]
    n = l // RET_CHUNK

    def chunks(t):
        return t.reshape(b, h, n, RET_CHUNK, t.shape[-1]).transpose(2, 0, 1, 3, 4)

    qn, kn, vn = chunks(q), chunks(k), chunks(v)
    idx = jnp.arange(RET_CHUNK, dtype=jnp.float32)
    lg = log_gamma.astype(jnp.float32)[:, None]
    diff = idx[:, None] - idx[None, :]
    dmask = jnp.where(diff >= 0, jnp.exp(lg[:, :, None] * jnp.maximum(diff, 0.0)), 0.0)
    q_dec = jnp.exp(lg * (idx + 1.0))[:, :, None]
    k_dec = jnp.exp(lg * (RET_CHUNK - 1.0 - idx))[:, :, None]
    c_dec = jnp.exp(log_gamma.astype(jnp.float32) * RET_CHUNK)[:, None, None]
    intra = jnp.einsum('nbhij,nbhje->nbhie',
                       jnp.einsum('nbhid,nbhjd->nbhij', qn, kn) * dmask, vn)

    def step(s, inp):
        qd, kd, vc = inp
        cross = jnp.einsum('bhid,bhde->bhie', qd, s)
        s = s * c_dec + jnp.einsum('bhjd,bhje->bhde', kd, vc)
        return s, cross

    s_fin, cross = lax.scan(step, s0, (qn * q_dec, kn * k_dec, vn))
    o = (intra + cross).transpose(1, 2, 0, 3, 4).reshape(b, h, l, dv)
    return o, s_fin


def gdn_chunked(q, k, v, g, beta, s0):
    b, h, l, dk = q.shape
    dv = v.shape[-1]
    n = l // GDN_CHUNK

    def chunks(t):
        return t.reshape(b, h, n, GDN_CHUNK, t.shape[-1]).transpose(2, 0, 1, 3, 4)

    qn = chunks(q) * dk ** -0.5
    kn, vn = chunks(k), chunks(v)
    gn = g.reshape(b, h, n, GDN_CHUNK).transpose(2, 0, 1, 3)
    bn = beta.reshape(b, h, n, GDN_CHUNK).transpose(2, 0, 1, 3)
    gc = jnp.cumsum(gn, axis=-1)
    idx = jnp.arange(GDN_CHUNK)
    tri = idx[:, None] >= idx[None, :]
    strict = idx[:, None] > idx[None, :]
    decay = jnp.exp(jnp.where(tri, gc[..., :, None] - gc[..., None, :], -jnp.inf))
    kk = jnp.einsum('nbhid,nbhjd->nbhij', kn, kn)
    m = jnp.where(strict, kk * bn[..., :, None] * decay, 0.0)
    t_mat = m + jnp.eye(GDN_CHUNK, dtype=jnp.float32)
    rhs = jnp.concatenate([vn * bn[..., None], kn * (bn * jnp.exp(gc))[..., None]], axis=-1)
    sol = lax.linalg.triangular_solve(t_mat, rhs, left_side=True, lower=True,
                                      unit_diagonal=True)
    u, w = sol[..., :dv], sol[..., dv:]
    attn = jnp.einsum('nbhid,nbhjd->nbhij', qn, kn) * decay
    q_dec = qn * jnp.exp(gc)[..., None]
    k_tail = kn * jnp.exp(gc[..., -1:] - gc)[..., None]
    g_tot = jnp.exp(gc[..., -1])[..., None, None]

    def step(s, inp):
        u_i, w_i, a_i, qd_i, kt_i, gt_i = inp
        v_new = u_i - jnp.einsum('bhid,bhde->bhie', w_i, s)
        o_i = jnp.einsum('bhid,bhde->bhie', qd_i, s) + jnp.einsum('bhij,bhje->bhie', a_i, v_new)
        s = s * gt_i + jnp.einsum('bhjd,bhje->bhde', kt_i, v_new)
        return s, o_i

    s_fin, o = lax.scan(step, s0, (u, w, attn, q_dec, k_tail, g_tot))
    o = o.transpose(1, 2, 0, 3, 4).reshape(b, h, l, dv)
    return o, s_fin


def swa_latent(q, k, v, k_ctx, v_ctx, sinks):
    b, hq, l, d = q.shape
    g = hq // SWA_KV_HEADS
    lc = k_ctx.shape[2]
    nblk = l // Q_BLOCK
    span = Q_BLOCK + 2 * WINDOW
    qg = q.reshape(b, SWA_KV_HEADS, g, l, d)
    kp = jnp.pad(k, ((0, 0), (0, 0), (WINDOW, WINDOW), (0, 0)))
    vp = jnp.pad(v, ((0, 0), (0, 0), (WINDOW, WINDOW), (0, 0)))
    scale = d ** -0.5
    sink = jnp.broadcast_to(sinks.astype(jnp.float32).reshape(1, SWA_KV_HEADS, g, 1, 1),
                            (b, SWA_KV_HEADS, g, Q_BLOCK, 1))

    def block(i):
        start = i * Q_BLOCK
        qb = lax.dynamic_slice_in_dim(qg, start, Q_BLOCK, axis=3)
        kb = lax.dynamic_slice_in_dim(kp, start, span, axis=2)
        vb = lax.dynamic_slice_in_dim(vp, start, span, axis=2)
        qpos = start + jnp.arange(Q_BLOCK)
        kpos = start - WINDOW + jnp.arange(span)
        valid = ((jnp.abs(qpos[:, None] - kpos[None, :]) <= WINDOW)
                 & (kpos >= 0)[None, :] & (kpos < l)[None, :])
        s_loc = jnp.einsum('bkgqd,bkjd->bkgqj', qb, kb).astype(jnp.float32) * scale
        s_loc = jnp.where(valid, s_loc, NEG_INF)
        s_ctx = jnp.einsum('bkgqd,bkjd->bkgqj', qb, k_ctx).astype(jnp.float32) * scale
        p = jax.nn.softmax(jnp.concatenate([s_loc, s_ctx, sink], axis=-1), axis=-1)
        p_loc = p[..., :span].astype(v.dtype)
        p_ctx = p[..., span:span + lc].astype(v.dtype)
        return (jnp.einsum('bkgqj,bkjd->bkgqd', p_loc, vb)
                + jnp.einsum('bkgqj,bkjd->bkgqd', p_ctx, v_ctx))

    out = lax.map(block, jnp.arange(nblk))
    return out.transpose(1, 2, 3, 0, 4, 5).reshape(b, hq, l, d)


def swa_context(q, k, v, sinks):
    b, hq, lc, d = q.shape
    g = hq // SWA_KV_HEADS
    qg = q.reshape(b, SWA_KV_HEADS, g, lc, d)
    s = jnp.einsum('bkgqd,bkjd->bkgqj', qg, k).astype(jnp.float32) * d ** -0.5
    sink = jnp.broadcast_to(sinks.astype(jnp.float32).reshape(1, SWA_KV_HEADS, g, 1, 1),
                            (b, SWA_KV_HEADS, g, lc, 1))
    p = jax.nn.softmax(jnp.concatenate([s, sink], axis=-1), axis=-1)[..., :lc].astype(v.dtype)
    return jnp.einsum('bkgqj,bkjd->bkgqd', p, v).reshape(b, hq, lc, d)


def retention_group(pc, pl, cos, sin, ret_rate, norm_w, need_ctx):
    log_gamma = jnp.log1p(-jnp.exp2(-ret_rate.astype(jnp.float32)))

    def prep(q, k, v, rope):
        q, k, v = (heads(t.astype(jnp.float32), RET_HEADS) for t in (q, k, v))
        if rope:
            q, k = apply_rope(q, cos, sin), apply_rope(k, cos, sin)
        return q, k * HEAD_DIM ** -0.5, v

    qc, kc, vc = prep(pc[0], pc[1], pc[2], False)
    ql, kl, vl = prep(pl[0], pl[1], pl[2], True)
    s0 = jnp.zeros((qc.shape[0], RET_HEADS, HEAD_DIM, HEAD_DIM), jnp.float32)
    oc_f, s_f = retention_chunked(qc, kc, vc, log_gamma[0], s0)
    oc_b, s_b = retention_chunked(flip(qc), flip(kc), flip(vc), log_gamma[1], s0)
    ol_f, _ = retention_chunked(ql, kl, vl, log_gamma[0], s_f)
    ol_b, _ = retention_chunked(flip(ql), flip(kl), flip(vl), log_gamma[1], s_b)

    def out(o, gate):
        y = merge(head_rms(o)) * norm_w.astype(jnp.float32) * jax.nn.silu(gate.astype(jnp.float32))
        return y.astype(gate.dtype)

    y_l = out(ol_f + flip(ol_b), pl[3])
    y_c = out(oc_f + flip(oc_b), pc[3]) if need_ctx else None
    return y_l, y_c


def swa_group(pc, pl, cos, sin, sinks, need_ctx):
    qc, kc, vc = heads(pc[0], SWA_Q_HEADS), heads(pc[1], SWA_KV_HEADS), heads(pc[2], SWA_KV_HEADS)
    ql = apply_rope(heads(pl[0], SWA_Q_HEADS), cos, sin)
    kl = apply_rope(heads(pl[1], SWA_KV_HEADS), cos, sin)
    vl = heads(pl[2], SWA_KV_HEADS)
    y_l = merge(swa_latent(ql, kl, vl, kc, vc, sinks))
    y_c = merge(swa_context(qc, kc, vc, sinks)) if need_ctx else None
    return y_l, y_c


def gdn_group(pc, pl, conv_w, a_log, dt_bias, norm_w, need_ctx):
    a_rate = jnp.exp(a_log.astype(jnp.float32))
    dtb = dt_bias.astype(jnp.float32)

    def prep(q, k, v, a, bg):
        b, l, _ = q.shape
        qkv = jax.nn.silu(short_conv(jnp.concatenate([q, k, v], axis=-1).astype(jnp.float32),
                                     conv_w.astype(jnp.float32)))
        q, k, v = (heads(qkv[..., i * GDN_W:(i + 1) * GDN_W], GDN_HEADS) for i in range(3))
        a = a.astype(jnp.float32).reshape(b, l, 2, GDN_HEADS)
        bg = bg.astype(jnp.float32).reshape(b, l, 2, GDN_HEADS)
        g = (-a_rate * jax.nn.softplus(a + dtb)).transpose(2, 0, 3, 1)
        beta = jax.nn.sigmoid(bg).transpose(2, 0, 3, 1)
        return l2norm(q), l2norm(k), v, g, beta

    qc, kc, vc, gcx, bc = prep(pc[0], pc[1], pc[2], pc[4], pc[5])
    ql, kl, vl, glt, bl = prep(pl[0], pl[1], pl[2], pl[4], pl[5])
    s0 = jnp.zeros((qc.shape[0], GDN_HEADS, HEAD_DIM, HEAD_DIM), jnp.float32)
    oc_f, s_f = gdn_chunked(qc, kc, vc, gcx[0], bc[0], s0)
    oc_b, s_b = gdn_chunked(flip(qc), flip(kc), flip(vc), flip(gcx[1]), flip(bc[1]), s0)
    ol_f, _ = gdn_chunked(ql, kl, vl, glt[0], bl[0], s_f)
    ol_b, _ = gdn_chunked(flip(ql), flip(kl), flip(vl), flip(glt[1]), flip(bl[1]), s_b)

    def out(o, z):
        y = merge(head_rms(o) * norm_w.astype(jnp.float32)) * jax.nn.silu(z.astype(jnp.float32))
        return y.astype(z.dtype)

    y_l = out(ol_f + flip(ol_b), pl[3])
    y_c = out(oc_f + flip(oc_b), pc[3]) if need_ctx else None
    return y_l, y_c


def mixer(hc, hl, cos, sin, w_in, ret_rate, ret_norm_w, sinks, conv_w, a_log, dt_bias,
          gdn_norm_w, w_out, need_ctx):
    pl = split_proj(hl @ w_in)
    pc = split_proj(hc @ w_in)
    r_l, r_c = retention_group(pc[0:4], pl[0:4], cos, sin, ret_rate, ret_norm_w, need_ctx)
    s_l, s_c = swa_group(pc[4:7], pl[4:7], cos, sin, sinks, need_ctx)
    g_l, g_c = gdn_group(pc[7:13], pl[7:13], conv_w, a_log, dt_bias, gdn_norm_w, need_ctx)
    y_l = jnp.concatenate([r_l, s_l, g_l], axis=-1) @ w_out
    y_c = jnp.concatenate([r_c, s_c, g_c], axis=-1) @ w_out if need_ctx else None
    return y_l, y_c


def swiglu(h, w1, w2):
    gu = h @ w1
    return (jax.nn.silu(gu[..., :D_FF]) * gu[..., D_FF:]) @ w2


def setup_inputs(seed: int = 0) -> dict:
    key = jax.random.key(seed)
    ks = jax.random.split(key, 20)

    def nrm(k, shape, scale):
        return jax.random.normal(k, shape, jnp.float32) * scale

    dt = jnp.exp(jax.random.uniform(ks[15], (DEPTH, 2, GDN_HEADS), jnp.float32,
                                    minval=np.log(1e-3), maxval=np.log(1e-1)))
    return {
        'x': nrm(ks[0], (BATCH, SEQ, D_MODEL), 1.0),
        'c': nrm(ks[1], (BATCH, D_MODEL), 1.0),
        'ctx': nrm(ks[2], (BATCH, CTX_LEN, D_MODEL), 1.0),
        'c_ctx': nrm(ks[3], (D_MODEL,), 1.0),
        'ada_w': nrm(ks[4], (DEPTH, D_MODEL, N_MOD * D_MODEL), 0.5 * D_MODEL ** -0.5),
        'ada_b': nrm(ks[5], (DEPTH, N_MOD * D_MODEL), 0.02),
        'norm_mix_w': 1.0 + nrm(ks[6], (DEPTH, D_MODEL), 0.02),
        'norm_ffn_w': 1.0 + nrm(ks[7], (DEPTH, D_MODEL), 0.02),
        'w_in': nrm(ks[8], (DEPTH, D_MODEL, IN_W), D_MODEL ** -0.5),
        'ret_rate': 5.0 + jnp.arange(RET_HEADS, dtype=jnp.float32) + nrm(ks[9], (DEPTH, 2, RET_HEADS), 0.1),
        'ret_norm_w': 1.0 + nrm(ks[10], (DEPTH, RET_W), 0.02),
        'swa_sinks': nrm(ks[11], (DEPTH, SWA_Q_HEADS), 1.0),
        'gdn_conv_w': nrm(ks[12], (DEPTH, CONV_W, 3 * GDN_W), CONV_W ** -0.5),
        'gdn_a_log': jnp.log(jax.random.uniform(ks[13], (DEPTH, 2, GDN_HEADS), jnp.float32,
                                                minval=1.0, maxval=16.0)),
        'gdn_dt_bias': dt + jnp.log(-jnp.expm1(-dt)),
        'gdn_norm_w': 1.0 + nrm(ks[14], (DEPTH, HEAD_DIM), 0.02),
        'w_out': nrm(ks[16], (DEPTH, MIX_W, D_MODEL), MIX_W ** -0.5),
        'w_ffn_in': nrm(ks[17], (DEPTH, D_MODEL, 2 * D_FF), D_MODEL ** -0.5),
        'w_ffn_out': nrm(ks[18], (DEPTH, D_FF, D_MODEL), D_FF ** -0.5),
        'final_norm_w': 1.0 + nrm(ks[19], (D_MODEL,), 0.02),
    }


def reference(x, c, ctx, c_ctx, ada_w, ada_b, norm_mix_w, norm_ffn_w, w_in, ret_rate,
              ret_norm_w, swa_sinks, gdn_conv_w, gdn_a_log, gdn_dt_bias, gdn_norm_w, w_out,
              w_ffn_in, w_ffn_out, final_norm_w):
    l = x.shape[1]
    rows = l // GRID_W
    cos, sin = axial_rope(rows)
    c_s = jax.nn.silu(c)
    cc_s = jax.nn.silu(c_ctx)
    xc = ctx
    for layer in range(DEPTH):
        need_ctx = layer < DEPTH - 1
        mod = (c_s @ ada_w[layer] + ada_b[layer])[:, None, :]
        sh1, sc1, g1, sh2, sc2, g2 = jnp.split(mod, N_MOD, axis=-1)
        modc = cc_s @ ada_w[layer] + ada_b[layer]
        shc1, scc1, gc1, shc2, scc2, gc2 = jnp.split(modc, N_MOD, axis=-1)
        hl = rmsnorm(x, norm_mix_w[layer]) * (1.0 + sc1) + sh1
        hc = rmsnorm(xc, norm_mix_w[layer]) * (1.0 + scc1) + shc1
        y_l, y_c = mixer(hc, hl, cos, sin, w_in[layer], ret_rate[layer], ret_norm_w[layer],
                         swa_sinks[layer], gdn_conv_w[layer], gdn_a_log[layer],
                         gdn_dt_bias[layer], gdn_norm_w[layer], w_out[layer], need_ctx)
        x = x + g1 * y_l
        x = x + g2 * swiglu(rmsnorm(x, norm_ffn_w[layer]) * (1.0 + sc2) + sh2,
                            w_ffn_in[layer], w_ffn_out[layer])
        if need_ctx:
            xc = xc + gc1 * y_c
            xc = xc + gc2 * swiglu(rmsnorm(xc, norm_ffn_w[layer]) * (1.0 + scc2) + shc2,
                                   w_ffn_in[layer], w_ffn_out[layer])
    return rmsnorm(x, final_norm_w)
```

```cpp
#ifndef HOST_TEST
#include <hip/hip_runtime.h>
#include <hip/hip_cooperative_groups.h>
#include <cstdio>
namespace cg = cooperative_groups;
#define DEV __device__ __forceinline__
#else
#include <cstdio>
#include <cstdlib>
#include <cmath>
#include <cstring>
#include <vector>
#include <string>
#define DEV static inline
#endif
#include <cstdint>

#ifndef D_MODEL
#define D_MODEL 1024
#endif
#ifndef BATCH
#define BATCH 8
#endif
#ifndef SEQ
#define SEQ 4096
#endif
#ifndef CTX_LEN
#define CTX_LEN 256
#endif

constexpr int DM = D_MODEL, NB = BATCH, SQ = SEQ, CTX = CTX_LEN;
constexpr int TPB = CTX + SQ;
constexpr int DFF = ((8 * DM + 767) / 768) * 256;
constexpr int INW = 2832;
constexpr int NMOD = 6;
constexpr int HB = NB / 2;
constexpr int HROWS = HB * TPB;
constexpr int C_RQ = 0, C_RK = 256, C_RV = 512, C_RG = 768, C_SQ = 1024, C_SK = 1536, C_SV = 1664,
              C_GQ = 1792, C_GK = 2048, C_GV = 2304, C_GZ = 2560, C_GA = 2816, C_GB = 2824;

struct Params {
    const float *x, *c, *ctx, *c_ctx, *ada_w, *ada_b, *norm_mix_w, *norm_ffn_w, *w_in, *ret_rate, *ret_norm_w,
        *swa_sinks, *gdn_conv_w, *gdn_a_log, *gdn_dt_bias, *gdn_norm_w, *w_out, *w_ffn_in, *w_ffn_out, *final_norm_w;
    float* XL;
    float* XC;
    float* MOD;
    float* ROPE;
    float* H;
    float* P;
    float* OR;
    float* OG;
    float* GQ;
    float* GBt;
};

DEV float siluf(float x) { return x / (1.0f + expf(-x)); }
DEV float sigmf(float x) { return 1.0f / (1.0f + expf(-x)); }
DEV float softplusf(float x) { return x > 20.f ? x : log1pf(expf(x)); }

DEV float* xrow(const Params& p, int R) {
    int b = R / TPB, s = R % TPB;
    return s < CTX ? p.XC + ((size_t)b * CTX + s) * DM : p.XL + ((size_t)b * SQ + (s - CTX)) * DM;
}
DEV int modrow(int R) { int b = R / TPB, s = R % TPB; return s < CTX ? NB : b; }

DEV void ph_init(const Params& p, long gtid, long gsize) {
    for (long i = gtid; i < (long)NB * SQ * DM; i += gsize) p.XL[i] = p.x[i];
    for (long i = gtid; i < (long)NB * CTX * DM; i += gsize) p.XC[i] = p.ctx[i];
    for (long i = gtid; i < (long)2 * (NB + 1) * NMOD * DM; i += gsize) {
        int col = (int)(i % (NMOD * DM));
        int r = (int)((i / (NMOD * DM)) % (NB + 1));
        int l = (int)(i / ((long)(NMOD * DM) * (NB + 1)));
        const float* cv = r < NB ? p.c + (size_t)r * DM : p.c_ctx;
        const float* w = p.ada_w + (size_t)l * DM * NMOD * DM + col;
        float acc = 0.f;
        for (int k = 0; k < DM; ++k) acc += siluf(cv[k]) * w[(size_t)k * NMOD * DM];
        p.MOD[i] = acc + p.ada_b[(size_t)l * NMOD * DM + col];
    }
    for (long i = gtid; i < 64 * 16; i += gsize) {
        int pos = (int)(i / 16), f = (int)(i % 16);
        double fr = pow(10000.0, -(double)f / 16.0);
        double ang = (double)pos * fr;
        p.ROPE[i * 2 + 0] = (float)cos(ang);
        p.ROPE[i * 2 + 1] = (float)sin(ang);
    }
}

DEV void ph_norm(const Params& p, int layer, int half, int which  , bool skip_ctx, long gtid, long gsize) {
    const float* nw = (which == 0 ? p.norm_mix_w : p.norm_ffn_w) + (size_t)layer * DM;
    for (long r = gtid; r < HROWS; r += gsize) {
        int R = half * HROWS + (int)r;
        if (skip_ctx && (R % TPB) < CTX) continue;
        const float* xr = xrow(p, R);
        float ss = 0.f;
        for (int k = 0; k < DM; ++k) ss += xr[k] * xr[k];
        float rs = 1.0f / sqrtf(ss / DM + 1e-6f);
        const float* md = p.MOD + ((size_t)layer * (NB + 1) + modrow(R)) * NMOD * DM;
        const float* sh = md + (which == 0 ? 0 : 3 * DM);
        const float* sc = md + (which == 0 ? 1 * DM : 4 * DM);
        float* h = p.H + (size_t)r * DM;
        for (int k = 0; k < DM; ++k) h[k] = xr[k] * rs * nw[k] * (1.0f + sc[k]) + sh[k];
    }
}

DEV void gemm_store(const Params& p, int MODE, int layer, int half, int r, int n, int N, float a1, float a2, float* C) {
    if (MODE == 0) C[(size_t)r * N + n] = a1;
    else if (MODE == 2) C[(size_t)r * N + n] = siluf(a1) * a2;
    else {
        int R = half * HROWS + r;
        const float* md = p.MOD + ((size_t)layer * (NB + 1) + modrow(R)) * NMOD * DM;
        float g = md[(MODE == 1 ? 2 : 5) * DM + n];
        xrow(p, R)[n] += g * a1;
    }
}

#ifdef HOST_TEST
static void gemm_host(const Params& p, int MODE, int layer, int half, const float* A, int K, const float* B, int ldb, int N, float* C, bool skip_ctx) {
    for (int r = 0; r < HROWS; ++r) {
        int R = half * HROWS + r;
        if (skip_ctx && (R % TPB) < CTX) continue;
        for (int n = 0; n < N; ++n) {
            double a1 = 0, a2 = 0;
            for (int k = 0; k < K; ++k) {
                a1 += (double)A[(size_t)r * K + k] * B[(size_t)k * ldb + n];
                if (MODE == 2) a2 += (double)A[(size_t)r * K + k] * B[(size_t)k * ldb + n + N];
            }
            gemm_store(p, MODE, layer, half, r, n, N, (float)a1, (float)a2, C);
        }
    }
}
#else
template <int MODE>
__device__ void gemm_dev(const Params& p, int layer, int half, const float* __restrict__ A, int K, const float* __restrict__ B, int ldb,
                         int N, float* C, bool skip_ctx, float* smem) {
    float(*As)[68] = (float(*)[68])smem;
    float(*Bs)[64] = (float(*)[64])(smem + 16 * 68);
    float(*Bs2)[64] = (float(*)[64])(smem + 16 * 68 + 16 * 64);
    const int tid = threadIdx.x, ty = tid / 16, tx = tid % 16;
    const int ntn = (N + 63) / 64, ntm = HROWS / 64;
    for (int tile = blockIdx.x; tile < ntm * ntn; tile += gridDim.x) {
        const int tm = tile / ntn, tn = tile % ntn;
        const int r0 = tm * 64, n0 = tn * 64;
        if (skip_ctx && ((half * HROWS + r0) % TPB) < CTX) continue;
        float acc[4][4], acc2[4][4];
#pragma unroll
        for (int i = 0; i < 4; ++i)
#pragma unroll
            for (int j = 0; j < 4; ++j) { acc[i][j] = 0.f; acc2[i][j] = 0.f; }
        for (int k0 = 0; k0 < K; k0 += 16) {
            {
                const int row = tid / 4, kq = (tid % 4) * 4;
                const float4 v = *(const float4*)(A + (size_t)(r0 + row) * K + k0 + kq);
                As[kq + 0][row] = v.x; As[kq + 1][row] = v.y; As[kq + 2][row] = v.z; As[kq + 3][row] = v.w;
                const int kr = tid / 16, cc = (tid % 16) * 4;
                float4 b = make_float4(0.f, 0.f, 0.f, 0.f), b2 = b;
                if (n0 + cc < N) {
                    b = *(const float4*)(B + (size_t)(k0 + kr) * ldb + n0 + cc);
                    if (MODE == 2) b2 = *(const float4*)(B + (size_t)(k0 + kr) * ldb + n0 + cc + N);
                }
                *(float4*)&Bs[kr][cc] = b;
                if (MODE == 2) *(float4*)&Bs2[kr][cc] = b2;
            }
            __syncthreads();
#pragma unroll
            for (int kk = 0; kk < 16; ++kk) {
                const float4 a = *(const float4*)&As[kk][ty * 4];
                const float4 b = *(const float4*)&Bs[kk][tx * 4];
                const float av[4] = {a.x, a.y, a.z, a.w}, bv[4] = {b.x, b.y, b.z, b.w};
#pragma unroll
                for (int i = 0; i < 4; ++i)
#pragma unroll
                    for (int j = 0; j < 4; ++j) acc[i][j] += av[i] * bv[j];
                if (MODE == 2) {
                    const float4 c2 = *(const float4*)&Bs2[kk][tx * 4];
                    const float cv[4] = {c2.x, c2.y, c2.z, c2.w};
#pragma unroll
                    for (int i = 0; i < 4; ++i)
#pragma unroll
                        for (int j = 0; j < 4; ++j) acc2[i][j] += av[i] * cv[j];
                }
            }
            __syncthreads();
        }
#pragma unroll
        for (int i = 0; i < 4; ++i)
#pragma unroll
            for (int j = 0; j < 4; ++j) {
                const int r = r0 + ty * 4 + i, n = n0 + tx * 4 + j;
                if (n < N) gemm_store(p, MODE, layer, half, r, n, N, acc[i][j], acc2[i][j], C);
            }
    }
}
#endif

DEV void rope_head(const Params& p, float* v, int t, float scale) {
    const int rowi = t / 64, coli = t % 64;
    for (int a = 0; a < 2; ++a) {
        const int pos = a == 0 ? rowi : coli;
        for (int f = 0; f < 16; ++f) {
            const float cs = p.ROPE[(pos * 16 + f) * 2], sn = p.ROPE[(pos * 16 + f) * 2 + 1];
            const float t1 = v[a * 32 + f], t2 = v[a * 32 + 16 + f];
            v[a * 32 + f] = (t1 * cs - t2 * sn) * scale;
            v[a * 32 + 16 + f] = (t1 * sn + t2 * cs) * scale;
        }
    }
}

DEV void ph_pre(const Params& p, int layer, int half, long gtid, long gsize) {
    for (long it = gtid; it < (long)HROWS * 31; it += gsize) {
        const int r = (int)(it / 31), j = (int)(it % 31);
        const int R = half * HROWS + r, s = R % TPB;
        const bool lat = s >= CTX;
        float* pr = p.P + (size_t)r * INW;
        if (j < 18) {
            int col; float scale = 1.f;
            if (j < 4) col = C_RQ + j * 64;
            else if (j < 8) { col = C_RK + (j - 4) * 64; scale = 0.125f; }
            else if (j < 16) col = C_SQ + (j - 8) * 64;
            else col = C_SK + (j - 16) * 64;
            if (lat) rope_head(p, pr + col, s - CTX, scale);
            else if (scale != 1.f) for (int d = 0; d < 64; ++d) pr[col + d] *= scale;
        } else if (j < 30) {
            const int which = (j - 18) / 4, h = (j - 18) % 4;
            const int col = C_GQ + which * 256 + h * 64;
            const int cc = which * 256 + h * 64;
            const float* cw = p.gdn_conv_w + (size_t)layer * 3 * 768;
            const int seq_lo = lat ? CTX : 0, seq_hi = lat ? TPB : CTX;
            const bool hasp = s - 1 >= seq_lo, hasn = s + 1 < seq_hi;
            float ss = 0.f;
            float* o = p.GQ + (size_t)r * 768 + cc;
            for (int d = 0; d < 64; ++d) {
                float a = cw[768 + cc + d] * pr[col + d];
                if (hasp) a += cw[cc + d] * (pr - INW)[col + d];
                if (hasn) a += cw[2 * 768 + cc + d] * (pr + INW)[col + d];
                a = siluf(a);
                o[d] = a; ss += a * a;
            }
            const float sc = which < 2 ? 1.0f / sqrtf(ss + 1e-6f) : 1.0f;
            for (int d = 0; d < 64; ++d) o[d] *= sc;
        } else {
            float* o = p.GBt + (size_t)r * 16;
            for (int q = 0; q < 8; ++q) {
                const float arate = expf(p.gdn_a_log[layer * 8 + q]);
                const float dtb = p.gdn_dt_bias[layer * 8 + q];
                o[q] = -arate * softplusf(pr[C_GA + q] + dtb);
                o[8 + q] = sigmf(pr[C_GB + q]);
            }
        }
    }
}

DEV int seq_pos(int dir, int step) {
    if (dir == 0) return step;
    return step < CTX ? CTX - 1 - step : CTX + (SQ - 1 - (step - CTX));
}

DEV void ret_scan(const Params& p, int layer, int bl, int h, int e) {
    for (int dir = 0; dir < 2; ++dir) {
        const float rate = p.ret_rate[layer * 8 + dir * 4 + h];
        const float gamma = expf(log1pf(-exp2f(-rate)));
        float S[64];
#pragma unroll
        for (int d = 0; d < 64; ++d) S[d] = 0.f;
        for (int step = 0; step < TPB; ++step) {
            const int r = bl * TPB + seq_pos(dir, step);
            const float* pr = p.P + (size_t)r * INW;
            const float v = pr[C_RV + h * 64 + e];
            float o = 0.f;
#pragma unroll
            for (int d = 0; d < 64; ++d) {
                S[d] = gamma * S[d] + pr[C_RK + h * 64 + d] * v;
                o += pr[C_RQ + h * 64 + d] * S[d];
            }
            float* op = p.OR + (size_t)r * 256 + h * 64 + e;
            if (dir == 0) *op = o; else *op += o;
        }
    }
}

DEV void gdn_scan(const Params& p, int layer, int bl, int h, int e) {
    (void)layer;
    for (int dir = 0; dir < 2; ++dir) {
        float S[64];
#pragma unroll
        for (int d = 0; d < 64; ++d) S[d] = 0.f;
        for (int step = 0; step < TPB; ++step) {
            const int r = bl * TPB + seq_pos(dir, step);
            const float* gq = p.GQ + (size_t)r * 768;
            const float g = p.GBt[(size_t)r * 16 + dir * 4 + h], beta = p.GBt[(size_t)r * 16 + 8 + dir * 4 + h];
            const float eg = expf(g);
            float ks = 0.f;
#pragma unroll
            for (int d = 0; d < 64; ++d) ks += gq[256 + h * 64 + d] * S[d];
            const float delta = beta * (gq[512 + h * 64 + e] - eg * ks);
            float o = 0.f;
#pragma unroll
            for (int d = 0; d < 64; ++d) {
                S[d] = eg * S[d] + gq[256 + h * 64 + d] * delta;
                o += gq[h * 64 + d] * S[d];
            }
            o *= 0.125f;
            float* op = p.OG + (size_t)r * 256 + h * 64 + e;
            if (dir == 0) *op = o; else *op += o;
        }
    }
}

DEV void swa_one(const Params& p, int layer, int half, int r, int hq) {
    const int R = half * HROWS + r, s = R % TPB;
    const int rb = r - s;
    const int kvh = hq / 4;
    const float* pq = p.P + (size_t)r * INW + C_SQ + hq * 64;
    float q[64], acc[64];
#pragma unroll
    for (int d = 0; d < 64; ++d) { q[d] = pq[d] * 0.125f; acc[d] = 0.f; }
    float m = p.swa_sinks[layer * 8 + hq], l = 1.0f;
    int lo2 = 0, hi2 = -1;
    if (s >= CTX) { const int t = s - CTX; lo2 = t - 128 < 0 ? 0 : t - 128; hi2 = t + 128 > SQ - 1 ? SQ - 1 : t + 128; lo2 += CTX; hi2 += CTX; }
    for (int seg = 0; seg < 2; ++seg) {
        const int lo = seg == 0 ? 0 : lo2, hi = seg == 0 ? CTX - 1 : hi2;
        for (int j = lo; j <= hi; ++j) {
            const float* pk = p.P + (size_t)(rb + j) * INW + C_SK + kvh * 64;
            const float* pv = p.P + (size_t)(rb + j) * INW + C_SV + kvh * 64;
            float sc = 0.f;
#pragma unroll
            for (int d = 0; d < 64; ++d) sc += q[d] * pk[d];
            const float mn = sc > m ? sc : m;
            const float f = expf(m - mn), pe = expf(sc - mn);
            l = l * f + pe;
#pragma unroll
            for (int d = 0; d < 64; ++d) acc[d] = acc[d] * f + pe * pv[d];
            m = mn;
        }
    }
    const float inv = 1.0f / l;
    float* o = p.H + (size_t)r * 1024 + 256 + hq * 64;
#pragma unroll
    for (int d = 0; d < 64; ++d) o[d] = acc[d] * inv;
}

DEV void ph_main(const Params& p, int layer, int half, bool need_ctx, long gtid, long gsize) {
    const long nscan = (long)HB * 4 * 64;
    for (long it = gtid; it < nscan; it += gsize) ret_scan(p, layer, (int)(it / 256), (int)((it / 64) % 4), (int)(it % 64));
    for (long it = gsize - 1 - gtid; it < nscan; it += gsize) gdn_scan(p, layer, (int)(it / 256), (int)((it / 64) % 4), (int)(it % 64));
    for (long it = gtid; it < (long)HROWS * 8; it += gsize) {
        const int r = (int)(it / 8), hq = (int)(it % 8);
        const int R = half * HROWS + r;
        if (!need_ctx && (R % TPB) < CTX) continue;
        swa_one(p, layer, half, r, hq);
    }
}

DEV void ph_post(const Params& p, int layer, int half, bool need_ctx, long gtid, long gsize) {
    for (long it = gtid; it < (long)HROWS * 8; it += gsize) {
        const int r = (int)(it / 8), j = (int)(it % 8);
        const int R = half * HROWS + r;
        if (!need_ctx && (R % TPB) < CTX) continue;
        const bool isg = j >= 4; const int h = j & 3;
        const float* o = (isg ? p.OG : p.OR) + (size_t)r * 256 + h * 64;
        const float* gate = p.P + (size_t)r * INW + (isg ? C_GZ : C_RG) + h * 64;
        const float* nw = isg ? p.gdn_norm_w + (size_t)layer * 64 : p.ret_norm_w + (size_t)layer * 256 + h * 64;
        float ss = 0.f;
        for (int d = 0; d < 64; ++d) ss += o[d] * o[d];
        const float rs = 1.0f / sqrtf(ss / 64.0f + 1e-6f);
        float* mx = p.H + (size_t)r * 1024 + (isg ? 768 : 0) + h * 64;
        for (int d = 0; d < 64; ++d) mx[d] = o[d] * rs * nw[d] * siluf(gate[d]);
    }
}

DEV void ph_final(const Params& p, long gtid, long gsize) {
    for (long r = gtid; r < (long)NB * SQ; r += gsize) {
        float* xr = p.XL + (size_t)r * DM;
        float ss = 0.f;
        for (int k = 0; k < DM; ++k) ss += xr[k] * xr[k];
        const float rs = 1.0f / sqrtf(ss / DM + 1e-6f);
        for (int k = 0; k < DM; ++k) xr[k] = xr[k] * rs * p.final_norm_w[k];
    }
}

#ifndef HOST_TEST
__global__ void __launch_bounds__(256) mega(Params p) {
    cg::grid_group grid = cg::this_grid();
    __shared__ float smem[16 * 68 + 2 * 16 * 64];
    const long gtid = (long)blockIdx.x * blockDim.x + threadIdx.x, gsize = (long)gridDim.x * blockDim.x;
    ph_init(p, gtid, gsize);
    grid.sync();
    for (int layer = 0; layer < 2; ++layer) {
        const bool need_ctx = layer == 0;
        for (int half = 0; half < 2; ++half) {
            ph_norm(p, layer, half, 0, false, gtid, gsize);
            grid.sync();
            gemm_dev<0>(p, layer, half, p.H, DM, p.w_in + (size_t)layer * DM * INW, INW, INW, p.P, false, smem);
            grid.sync();
            ph_pre(p, layer, half, gtid, gsize);
            grid.sync();
            ph_main(p, layer, half, need_ctx, gtid, gsize);
            grid.sync();
            ph_post(p, layer, half, need_ctx, gtid, gsize);
            grid.sync();
            gemm_dev<1>(p, layer, half, p.H, 1024, p.w_out + (size_t)layer * 1024 * DM, DM, DM, nullptr, !need_ctx, smem);
            grid.sync();
            ph_norm(p, layer, half, 1, !need_ctx, gtid, gsize);
            grid.sync();
            gemm_dev<2>(p, layer, half, p.H, DM, p.w_ffn_in + (size_t)layer * DM * 2 * DFF, 2 * DFF, DFF, p.P, !need_ctx, smem);
            grid.sync();
            gemm_dev<3>(p, layer, half, p.P, DFF, p.w_ffn_out + (size_t)layer * DFF * DM, DM, DM, nullptr, !need_ctx, smem);
            grid.sync();
        }
    }
    ph_final(p, gtid, gsize);
}

extern "C" void kernel_launch(void* const* d_in, const int* in_sizes, int n_in, void* d_out, int out_size, void* d_ws, size_t ws_size,
                              hipStream_t stream) {
    static int grid_blocks = 0;
    if (!grid_blocks) {
        int dev = 0, cus = 0, per_cu = 0;
        hipGetDevice(&dev);
        hipDeviceGetAttribute(&cus, hipDeviceAttributeMultiprocessorCount, dev);
        hipOccupancyMaxActiveBlocksPerMultiprocessor(&per_cu, mega, 256, 0);
        if (per_cu > 4) per_cu = 4;
        if (per_cu < 1) per_cu = 1;
        grid_blocks = cus * per_cu;
    }
    Params p{};
    const float** ip = (const float**)&p;
    for (int i = 0; i < 20; ++i) ip[i] = (const float*)d_in[i];
    char* ws = (char*)d_ws;
    size_t off = 0;
    auto carve = [&](size_t bytes) { char* q = ws + off; off += (bytes + 255) & ~(size_t)255; return (float*)q; };
    p.XL = (float*)d_out;
    p.XC = carve((size_t)NB * CTX * DM * 4);
    p.MOD = carve((size_t)2 * (NB + 1) * NMOD * DM * 4);
    p.ROPE = carve(64 * 16 * 2 * 4);
    p.H = carve((size_t)HROWS * 1024 * 4);
    p.P = carve((size_t)HROWS * INW * 4);
    p.OR = carve((size_t)HROWS * 256 * 4);
    p.OG = carve((size_t)HROWS * 256 * 4);
    p.GQ = carve((size_t)HROWS * 768 * 4);
    p.GBt = carve((size_t)HROWS * 16 * 4);
    if (off > ws_size) { fprintf(stderr, "ws too small: need %zu have %zu\n", off, ws_size); return; }
    void* args[] = {&p};
    hipError_t e = hipLaunchCooperativeKernel((void*)mega, dim3(grid_blocks), dim3(256), args, 0, stream);
    if (e != hipSuccess) fprintf(stderr, "cooperative launch failed: %s (grid %d)\n", hipGetErrorString(e), grid_blocks);
}
#else
static std::vector<float> rd(const std::string& f, size_t n) {
    std::vector<float> v(n);
    FILE* fp = fopen(f.c_str(), "rb");
    if (!fp) { printf("cannot open %s\n", f.c_str()); exit(1); }
    size_t got = fread(v.data(), 4, n, fp);
    if (got != n) { printf("short read %s: %zu of %zu\n", f.c_str(), got, n); exit(1); }
    fclose(fp);
    return v;
}
int main(int argc, char** argv) {
    std::string dir = argc > 1 ? argv[1] : "data";
    size_t sizes[20] = {(size_t)NB * SQ * DM, (size_t)NB * DM, (size_t)NB * CTX * DM, (size_t)DM, (size_t)2 * DM * NMOD * DM, (size_t)2 * NMOD * DM,
                        (size_t)2 * DM, (size_t)2 * DM, (size_t)2 * DM * INW, 16, 2 * 256, 16, 2 * 3 * 768, 16, 16, 2 * 64,
                        (size_t)2 * 1024 * DM, (size_t)2 * DM * 2 * DFF, (size_t)2 * DFF * DM, (size_t)DM};
    std::vector<std::vector<float>> in(20);
    for (int i = 0; i < 20; ++i) { char nm[64]; snprintf(nm, 64, "/in%02d.bin", i); in[i] = rd(dir + nm, sizes[i]); }
    std::vector<float> ref = rd(dir + "/out.bin", (size_t)NB * SQ * DM);
    Params p{};
    const float** ip = (const float**)&p;
    for (int i = 0; i < 20; ++i) ip[i] = in[i].data();
    std::vector<float> XL((size_t)NB * SQ * DM), XC((size_t)NB * CTX * DM), MOD((size_t)2 * (NB + 1) * NMOD * DM), ROPE(64 * 16 * 2),
        H((size_t)HROWS * 1024), P((size_t)HROWS * (INW > DFF ? INW : DFF)), OR_((size_t)HROWS * 256), OG((size_t)HROWS * 256), GQ((size_t)HROWS * 768), GBt((size_t)HROWS * 16);
    p.XL = XL.data(); p.XC = XC.data(); p.MOD = MOD.data(); p.ROPE = ROPE.data(); p.H = H.data(); p.P = P.data(); p.OR = OR_.data(); p.OG = OG.data(); p.GQ = GQ.data(); p.GBt = GBt.data();
    ph_init(p, 0, 1);
    for (int layer = 0; layer < 2; ++layer) {
        const bool need_ctx = layer == 0;
        for (int half = 0; half < 2; ++half) {
            ph_norm(p, layer, half, 0, false, 0, 1);
            gemm_host(p, 0, layer, half, p.H, DM, p.w_in + (size_t)layer * DM * INW, INW, INW, p.P, false);
            ph_pre(p, layer, half, 0, 1);
            ph_main(p, layer, half, need_ctx, 0, 1);
            ph_post(p, layer, half, need_ctx, 0, 1);
            {
                char nm[64]; snprintf(nm, 64, "/mix_l%d.bin", layer);
                std::vector<float> mref = rd(dir + nm, (size_t)NB * SQ * 1024);
                double num[3] = {0, 0, 0}, den[3] = {0, 0, 0};
                for (int r = 0; r < HROWS; ++r) {
                    int R = half * HROWS + r, b = R / TPB, s = R % TPB;
                    if (s < CTX) continue;
                    for (int c = 0; c < 1024; ++c) {
                        double a = p.H[(size_t)r * 1024 + c], e = mref[((size_t)b * SQ + s - CTX) * 1024 + c];
                        int g = c < 256 ? 0 : (c < 768 ? 1 : 2);
                        num[g] += (a - e) * (a - e); den[g] += e * e;
                    }
                }
                printf("layer %d half %d mix rvr: ret %.3e swa %.3e gdn %.3e\n", layer, half, num[0] / den[0], num[1] / den[1], num[2] / den[2]);
            }
            gemm_host(p, 1, layer, half, p.H, 1024, p.w_out + (size_t)layer * 1024 * DM, DM, DM, nullptr, !need_ctx);
            ph_norm(p, layer, half, 1, !need_ctx, 0, 1);
            gemm_host(p, 2, layer, half, p.H, DM, p.w_ffn_in + (size_t)layer * DM * 2 * DFF, 2 * DFF, DFF, p.P, !need_ctx);
            gemm_host(p, 3, layer, half, p.P, DFF, p.w_ffn_out + (size_t)layer * DFF * DM, DM, DM, nullptr, !need_ctx);
        }
    }
    ph_final(p, 0, 1);
    double num = 0, den = 0, amax = 0;
    for (size_t i = 0; i < ref.size(); ++i) { double d = (double)XL[i] - ref[i]; num += d * d; den += (double)ref[i] * ref[i]; if (fabs(d) > amax) amax = fabs(d); }
    printf("final rvr %.3e absmax %.3e\n", num / den, amax);
    return 0;
}
#endif
```

```cpp
#include <hip/hip_runtime.h>
#include <hip/hip_cooperative_groups.h>
#include <cstdio>
#include <cstdint>
namespace cg = cooperative_groups;
__device__ __forceinline__ int lane_id();
__device__ __forceinline__ int launder_s(int v);
namespace pg8 {
#define PG8_LAS __attribute__((address_space(3)))
typedef unsigned short bf16_t;
typedef short bf16x8 __attribute__((ext_vector_type(8)));
typedef float f32x4 __attribute__((ext_vector_type(4)));
typedef unsigned u32x4 __attribute__((ext_vector_type(4)));
constexpr int BM = 256, BK = 64, HALF = 128, HTB = HALF * BK * 2  , STAGE_BYTES = 8 * HTB, NXCD = 8, WGM = 8;

__host__ __device__ __forceinline__ int lds_byte(int r, int c) { const int st = (r >> 4) * 2 + (c >> 5), rr = r & 15, cc = c & 31, ob = rr * 64 + cc * 2; return st * 1024 + (ob ^ (((ob >> 9) & 1) << 5)); }
__host__ __device__ __forceinline__ void stage_rc(int b, int& R, int& C) { const int st = b / 1024, sb = b % 1024, swz = sb ^ (((sb >> 9) & 1) << 5); R = (st >> 1) * 16 + swz / 64; C = (st & 1) * 32 + (swz % 64) / 2; }
__host__ __device__ __forceinline__ int perm32(int rho) { const int n = rho >> 4, i = rho & 15; return 8 * (i >> 2) + 4 * n + (i & 3); }
struct Unit { int pm, pn; };
struct Gemm { const bf16_t* A; const bf16_t* Bt; int M, N, K; };
struct StaticOrder {
    int nM, nN, nwg, G, c;
    __host__ __device__ void init(int M, int N, int G_, int c_) { nM = M / BM; nN = N / BM; nwg = nM * nN; G = G_; c = c_; }
    __host__ __device__ bool next(int i, Unit& u) const {
        const long L = (long)i * G + c; if (L >= nwg) return false;
        int wgid = (int)L; { const int q = nwg / NXCD, r = nwg % NXCD, xcd = wgid % NXCD, off = wgid / NXCD; wgid = (xcd < r ? xcd * (q + 1) : r * (q + 1) + (xcd - r) * q) + off; }
        const int nig = WGM * nN, gid = wgid / nig, fm = gid * WGM, gsz = (nM - fm) < WGM ? (nM - fm) : WGM;
        u.pm = fm + ((wgid % nig) % gsz); u.pn = (wgid % nig) / gsz; return true;
    }
    __device__ __forceinline__ void a_ready(const Unit&) const {}
    __device__ __forceinline__ void done(const Unit&) const {}
};
__device__ __forceinline__ unsigned cvt_pk_bf16(float lo, float hi) { unsigned r; asm volatile("v_cvt_pk_bf16_f32 %0, %1, %2" : "=v"(r) : "v"(lo), "v"(hi)); return r; }
template <class Epi, class Sched, bool STAMP = false>
__device__ __forceinline__ void gemm_phase(PG8_LAS unsigned char* lds, const Gemm g, const Sched& S, const Epi& E, unsigned long long* stamps, int wave_s) {
    const int wid = launder_s(wave_s), tid = wid * 64 + lane_id(), lane = tid & 63, wr = wid >> 2, wc = wid & 3, fr = lane & 15, fq = lane >> 4;
    const int K = g.K, nt = K / BK;
    int ts_lo = 0, ts_hi = 0, nts = 0; const unsigned long long rt_entry = STAMP ? (unsigned long long)wall_clock64() : 0ull;
#define PG8_STAMP() do { if (STAMP && wid == 0 && nts < 64) { const unsigned long long _c = (unsigned long long)clock64(); \
        ts_lo = (lane == nts) ? (int)(unsigned)_c : ts_lo; ts_hi = (lane == nts) ? (int)(unsigned)(_c >> 32) : ts_hi; ++nts; } } while (0)
    PG8_STAMP();
    unsigned voffA[2], voffB[2];
#pragma unroll
    for (int i = 0; i < 2; ++i) { int R, C; stage_rc(tid * 16 + i * 8192, R, C); const int Rb = Epi::PERM ? ((R & ~31) + perm32(R & 31)) : R;
        voffA[i] = (unsigned)(R * K + C) * 2u; voffB[i] = (unsigned)(Rb * K + C) * 2u; }
    const size_t kstep = (size_t)(BK * 2);
    const size_t hstep = (size_t)HALF * K * 2;
    const size_t tstep = 2 * hstep;
    const unsigned ldsw = (unsigned)wid * 1024u;
    const int aoff = lds_byte(wr * 64 + fr, fq * 8), boff = lds_byte(wc * 32 + fr, fq * 8);
#define PG8_SA(b, h) (((b) * 2 + (h)) * HTB)
#define PG8_SB(b, h) ((4 + (b) * 2 + (h)) * HTB)
#define PG8_STAGE(bufoff, gbase, voff) do { _Pragma("unroll") for (int _i = 0; _i < 2; ++_i) \
        __builtin_amdgcn_global_load_lds((const unsigned*)((const char*)(gbase) + (voff)[_i]), (PG8_LAS unsigned*)(lds + (bufoff) + ldsw + _i * 8192), 16, 0, 0); } while (0)
#define PG8_LDA(dst, b, h) do { _Pragma("unroll") for (int m = 0; m < 4; ++m) _Pragma("unroll") for (int k = 0; k < 2; ++k) dst[m][k] = *(const PG8_LAS bf16x8*)(lds + PG8_SA(b, h) + aoff + m * 2048 + k * 1024); } while (0)
#define PG8_LDB(dst, b, h) do { _Pragma("unroll") for (int n = 0; n < 2; ++n) _Pragma("unroll") for (int k = 0; k < 2; ++k) dst[n][k] = *(const PG8_LAS bf16x8*)(lds + PG8_SB(b, h) + boff + n * 2048 + k * 1024); } while (0)
#define PG8_MMA(ai, bj, At, Bt) do { __builtin_amdgcn_s_setprio(1); _Pragma("unroll") for (int m = 0; m < 4; ++m) _Pragma("unroll") for (int n = 0; n < 2; ++n) _Pragma("unroll") for (int k = 0; k < 2; ++k) \
        acc[ai][bj][m][n] = __builtin_amdgcn_mfma_f32_16x16x32_bf16(Bt[n][k], At[m][k], acc[ai][bj][m][n], 0, 0, 0); __builtin_amdgcn_s_setprio(0); } while (0)
#define PG8_WAIT_V(n) asm volatile("s_waitcnt vmcnt(" #n ")" ::: "memory")
#define PG8_WAIT_L(n) asm volatile("s_waitcnt lgkmcnt(" #n ")" ::: "memory")
#define PG8_BAR __builtin_amdgcn_s_barrier()
#define PG8_SCHED __builtin_amdgcn_sched_barrier(0)
    Unit cur, nxt; int ui = 0;
    if (!S.next(0, cur)) return;
    f32x4 acc[2][2][4][2];
#pragma unroll
    for (int a = 0; a < 2; ++a)
#pragma unroll
        for (int b = 0; b < 2; ++b)
#pragma unroll
            for (int m = 0; m < 4; ++m)
#pragma unroll
                for (int n = 0; n < 2; ++n) acc[a][b][m][n] = (f32x4){0.f, 0.f, 0.f, 0.f};
    bf16x8 At[4][2], B0[2][2], B1[2][2];
    const char* cA = (const char*)g.A + (size_t)cur.pm * tstep; const char* cB = (const char*)g.Bt + (size_t)cur.pn * tstep;
    S.a_ready(cur);
    PG8_STAGE(PG8_SB(0, 0), cB, voffB); PG8_STAGE(PG8_SA(0, 0), cA, voffA); PG8_STAGE(PG8_SB(0, 1), cB + hstep, voffB); PG8_STAGE(PG8_SA(0, 1), cA + hstep, voffA);
    if (wr == 1) PG8_BAR;
    PG8_WAIT_V(4); PG8_BAR;
    PG8_STAGE(PG8_SB(1, 0), cB + kstep, voffB); PG8_STAGE(PG8_SA(1, 0), cA + kstep, voffA); PG8_STAGE(PG8_SB(1, 1), cB + hstep + kstep, voffB);
    PG8_WAIT_V(6); PG8_BAR;
    PG8_STAMP();
    for (;;) {
        const bool has_next = S.next(ui + 1, nxt);
        const char* nA = has_next ? (const char*)g.A + (size_t)nxt.pm * tstep : cA; const char* nB = has_next ? (const char*)g.Bt + (size_t)nxt.pn * tstep : cB;
        for (int t = 0; t < nt; t += 2) {
            const bool last = (t == nt - 2);
            const char* a1 = cA + (size_t)(t + 1) * kstep;
            const char* a2 = last ? nA : cA + (size_t)(t + 2) * kstep; const char* b2 = last ? nB : cB + (size_t)(t + 2) * kstep;
            const char* a3 = a2 + kstep; const char* b3 = b2 + kstep;
            if (last && has_next) S.a_ready(nxt);
            PG8_LDB(B0, 0, 0); PG8_SCHED; PG8_LDA(At, 0, 0); PG8_STAGE(PG8_SA(1, 1), a1 + hstep, voffA);
            PG8_WAIT_L(8); PG8_BAR; PG8_WAIT_L(0); PG8_MMA(0, 0, At, B0); PG8_BAR; PG8_SCHED;
            PG8_LDB(B1, 0, 1); PG8_STAGE(PG8_SB(0, 0), b2, voffB);
            PG8_BAR; PG8_WAIT_L(0); PG8_MMA(0, 1, At, B1); PG8_BAR;
            PG8_LDA(At, 0, 1); PG8_STAGE(PG8_SA(0, 0), a2, voffA);
            PG8_BAR; PG8_WAIT_L(0); PG8_MMA(1, 0, At, B0); PG8_BAR; PG8_SCHED;
            PG8_STAGE(PG8_SB(0, 1), b2 + hstep, voffB);
            PG8_WAIT_V(6); PG8_BAR; PG8_MMA(1, 1, At, B1); PG8_BAR;
            PG8_LDB(B0, 1, 0); PG8_SCHED; PG8_LDA(At, 1, 0); PG8_STAGE(PG8_SA(0, 1), a2 + hstep, voffA);
            PG8_WAIT_L(8); PG8_BAR; PG8_WAIT_L(0); PG8_MMA(0, 0, At, B0); PG8_BAR; PG8_SCHED;
            PG8_LDB(B1, 1, 1); PG8_STAGE(PG8_SB(1, 0), b3, voffB);
            PG8_BAR; PG8_WAIT_L(0); PG8_MMA(0, 1, At, B1); PG8_BAR;
            PG8_LDA(At, 1, 1); PG8_STAGE(PG8_SA(1, 0), a3, voffA);
            PG8_BAR; PG8_WAIT_L(0); PG8_MMA(1, 0, At, B0); PG8_BAR; PG8_SCHED;
            PG8_STAGE(PG8_SB(1, 1), b3 + hstep, voffB);
            PG8_WAIT_V(6); PG8_BAR; PG8_MMA(1, 1, At, B1); PG8_BAR;
        }
        PG8_STAMP();
        if constexpr (!Epi::AFTER_DRAIN) { E(acc, cur, wr, wc, fr, fq); S.done(cur); }
        PG8_STAMP();
        if (!has_next) break;
#pragma unroll
        for (int a = 0; a < 2; ++a)
#pragma unroll
            for (int b = 0; b < 2; ++b)
#pragma unroll
                for (int m = 0; m < 4; ++m)
#pragma unroll
                    for (int n = 0; n < 2; ++n) acc[a][b][m][n] = (f32x4){0.f, 0.f, 0.f, 0.f};
        cur = nxt; cA = nA; cB = nB; ++ui;
    }
    PG8_WAIT_V(0);
    if (wr == 0) PG8_BAR;
    PG8_BAR;
    if constexpr (Epi::AFTER_DRAIN) { E.fused(acc, cur, wr, wc, fr, fq, lds, wid, lane); S.done(cur); }
    PG8_STAMP();
    if (STAMP && wid == 0) { stamps[lane] = lane < nts ? (((unsigned long long)(unsigned)ts_hi << 32) | (unsigned)ts_lo) : 0ull;
        if (lane == 62) stamps[62] = rt_entry; if (lane == 63) stamps[63] = (unsigned long long)wall_clock64(); }
#undef PG8_STAMP
#undef PG8_SA
#undef PG8_SB
#undef PG8_STAGE
#undef PG8_LDA
#undef PG8_LDB
#undef PG8_MMA
#undef PG8_WAIT_V
#undef PG8_WAIT_L
#undef PG8_BAR
#undef PG8_SCHED
}
}

using pg8::bf16_t; using pg8::f32x4; using pg8::u32x4; using pg8::Unit;
#define LAS __attribute__((address_space(3)))
typedef unsigned u32x2 __attribute__((ext_vector_type(2)));
#define DEV __device__ __forceinline__

constexpr int NT = 512, NW = 8;
constexpr int DM = 1024, NB = 8, SQ = 4096, CTX = 256;
constexpr int NCR = NB * CTX;
constexpr int ROWS = NCR + NB * SQ;
constexpr int DFF = 2816, INW = 2832, PST = 2832, NPAD = 3072, NMOD = 6;
constexpr int C_RQ = 0, C_RK = 256, C_RV = 512, C_RG = 768, C_SQ = 1024, C_SK = 1536, C_SV = 1664,
              C_GQ = 1792, C_GK = 2048, C_GV = 2304, C_GZ = 2560, C_GA = 2816, C_GB = 2824;
constexpr int LDS_BYTES = 146 * 1024;

struct Params {
    const float *x, *c, *ctx, *c_ctx, *ada_w, *ada_b, *norm_mix_w, *norm_ffn_w, *w_in, *ret_rate, *ret_norm_w,
        *swa_sinks, *gdn_conv_w, *gdn_a_log, *gdn_dt_bias, *gdn_norm_w, *w_out, *w_ffn_in, *w_ffn_out, *final_norm_w;
    float* XL;
    char* ws;
};

constexpr size_t al256(size_t x) { return (x + 255) & ~(size_t)255; }
constexpr size_t O_XC = 0;
constexpr size_t O_MOD = O_XC + al256((size_t)NCR * DM * 4);
constexpr size_t O_ROPE = O_MOD + al256((size_t)2 * (NB + 1) * NMOD * DM * 4);
constexpr size_t O_WIN = O_ROPE + al256(64 * 16 * 2 * 4 + 64);
constexpr size_t O_WOUT = O_WIN + al256((size_t)2 * NPAD * DM * 2);
constexpr size_t O_WF1 = O_WOUT + al256((size_t)2 * DM * 1024 * 2);
constexpr size_t O_WF2 = O_WF1 + al256((size_t)2 * 2 * DFF * DM * 2);
constexpr size_t O_H = O_WF2 + al256((size_t)2 * DM * DFF * 2);
constexpr size_t O_P = O_H + al256((size_t)ROWS * 1024 * 2);
constexpr size_t O_OG = O_P + al256((size_t)ROWS * PST * 2);
constexpr size_t O_KT = O_OG;
constexpr size_t O_VT = O_KT + al256((size_t)NB * 2 * 68 * 4096 * 2);
constexpr size_t O_RKT = O_VT + al256((size_t)NB * 2 * 68 * 4096 * 2);
constexpr size_t O_RVT = O_RKT + al256((size_t)NB * 4 * 68 * 4096 * 2);
constexpr size_t O_RST = O_RVT + al256((size_t)NB * 4 * 68 * 4096 * 2);
constexpr size_t O_GKT = O_RST + al256((size_t)NB * 4 * 2 * 68 * 4096 * 2);
constexpr size_t O_GUT = O_GKT + al256((size_t)NB * 4 * 2 * 68 * 4096 * 2);
constexpr size_t O_GWN = O_GUT + al256((size_t)NB * 4 * 2 * 68 * 4096 * 2);
constexpr size_t O_GGC = O_GWN + al256((size_t)NB * 4 * 2 * 68 * 4096 * 2);
constexpr size_t O_NWSC = O_GGC + al256((size_t)NB * 4 * 68 * 128 * 4);
constexpr size_t O_BIAS = O_NWSC + al256((size_t)2 * 2 * 9 * 1024 * 4);
constexpr size_t O_SSQ = O_BIAS + al256((size_t)2 * 2 * 9 * 5632 * 4);
constexpr size_t O_BAR = O_SSQ + al256((size_t)ROWS * 16 * 4);
constexpr size_t BAR_BYTES = 3456 * 4 + 256;
constexpr size_t O_CTR = O_BAR + 3456 * 4;
constexpr size_t WS_END = O_BAR + al256(BAR_BYTES);
#define GAS __attribute__((address_space(1)))
#define CAS __attribute__((address_space(4)))
struct DParams {
    GAS const float *x, *c, *ctx, *c_ctx, *ada_w, *ada_b, *norm_mix_w, *norm_ffn_w, *w_in, *ret_rate, *ret_norm_w,
        *swa_sinks, *gdn_conv_w, *gdn_a_log, *gdn_dt_bias, *gdn_norm_w, *w_out, *w_ffn_in, *w_ffn_out, *final_norm_w;
    GAS float* XL;
    GAS char* ws;
};
DEV DParams load_params() {
    const CAS unsigned long long* kp = (const CAS unsigned long long*)__builtin_amdgcn_kernarg_segment_ptr();
    asm volatile("" : "+s"(kp));
    DParams r;
    r.x = (GAS const float*)kp[0]; r.c = (GAS const float*)kp[1]; r.ctx = (GAS const float*)kp[2]; r.c_ctx = (GAS const float*)kp[3];
    r.ada_w = (GAS const float*)kp[4]; r.ada_b = (GAS const float*)kp[5]; r.norm_mix_w = (GAS const float*)kp[6]; r.norm_ffn_w = (GAS const float*)kp[7];
    r.w_in = (GAS const float*)kp[8]; r.ret_rate = (GAS const float*)kp[9]; r.ret_norm_w = (GAS const float*)kp[10]; r.swa_sinks = (GAS const float*)kp[11];
    r.gdn_conv_w = (GAS const float*)kp[12]; r.gdn_a_log = (GAS const float*)kp[13]; r.gdn_dt_bias = (GAS const float*)kp[14]; r.gdn_norm_w = (GAS const float*)kp[15];
    r.w_out = (GAS const float*)kp[16]; r.w_ffn_in = (GAS const float*)kp[17]; r.w_ffn_out = (GAS const float*)kp[18]; r.final_norm_w = (GAS const float*)kp[19];
    r.XL = (GAS float*)kp[20]; r.ws = (GAS char*)kp[21];
    return r;
}
template <class T> DEV T* lp(GAS T* q) { return (T*)q; }
#define WSP(T, name, OFF) DEV T* name(const DParams& p) { return (T*)(lp(p.ws) + (OFF)); }
WSP(float, XC_, O_XC) WSP(float, MOD_, O_MOD) WSP(float, ROPE_, O_ROPE) WSP(bf16_t, WIN_, O_WIN) WSP(bf16_t, WOUT_, O_WOUT) WSP(bf16_t, WF1_, O_WF1)
WSP(bf16_t, WF2_, O_WF2) WSP(bf16_t, H_, O_H) WSP(bf16_t, P_, O_P)  WSP(bf16_t, KT_, O_KT) WSP(bf16_t, VT_, O_VT) WSP(bf16_t, RKT_, O_RKT) WSP(bf16_t, RVT_, O_RVT) WSP(bf16_t, RST_, O_RST) WSP(bf16_t, GKT_, O_GKT) WSP(bf16_t, GUT_, O_GUT) WSP(bf16_t, GWN_, O_GWN) WSP(float, GGC_, O_GGC) WSP(float, NWSC_, O_NWSC) WSP(float, BIAS_, O_BIAS) WSP(float, SSQ_, O_SSQ) WSP(bf16_t, A2_, O_RKT)

DEV int lane_id() { unsigned m = ~0u; asm volatile("" : "+s"(m)); return (int)__builtin_amdgcn_mbcnt_hi(m, __builtin_amdgcn_mbcnt_lo(m, 0u)); }
DEV int launder_s(int v) { asm volatile("" : "+s"(v)); return v; }
DEV int get_tid(int wave_s) { return launder_s(wave_s) * 64 + lane_id(); }
#define XB_TMO      128
#define XB_XCNT(j)  (256  + 64 * (j))
#define XB_XSUB(j)  (1280 + 64 * (j))
#define XB_XGEN(j)  (2304 + 64 * (j))
#define XB_TOP      3328
#define XB_TOPGEN   3392
#define XCD_BAR_WORDS 3456
#define XB_SPIN_CAP (1u << 18)

__device__ __forceinline__ unsigned xb_ld(unsigned* p)              { return __hip_atomic_load(p, __ATOMIC_RELAXED, __HIP_MEMORY_SCOPE_AGENT); }
__device__ __forceinline__ unsigned xb_add(unsigned* p, unsigned v) { return __hip_atomic_fetch_add(p, v, __ATOMIC_RELAXED, __HIP_MEMORY_SCOPE_AGENT); }
__device__ __forceinline__ unsigned xb_xcc_id() { return (unsigned)__builtin_amdgcn_s_getreg((3 << 11) | 20) & 0xFu; }
#define XB_SPIN(cond, bar) do { unsigned _sp = 0; while (cond) { __builtin_amdgcn_s_sleep(1); \
    if ((++_sp & 255u) == 0u) { if (xb_ld(&(bar)[XB_TMO])) break; if (_sp > XB_SPIN_CAP) { atomicAdd(&(bar)[XB_TMO], 1u); break; } } } } while (0)

struct XcdBarrier {
    unsigned* bar; unsigned x;
    volatile LAS unsigned* st;
};

__device__ __forceinline__ XcdBarrier xcd_barrier_post(unsigned* bar, volatile LAS unsigned* st, int tid) {
    XcdBarrier b; b.bar = bar; b.x = xb_xcc_id(); b.st = st;
    if (tid == 0) (void)xb_add(&bar[XB_XCNT(b.x)], 1u);
    return b;
}
__device__ __forceinline__ void xcd_barrier_complete(unsigned* bar, unsigned x, unsigned& nloc, unsigned& nx) {
    const unsigned G = gridDim.x * gridDim.y * gridDim.z;
    unsigned sum, cnt, mine, sp = 0u;
    for (;;) {
        sum = 0u; cnt = 0u; mine = 0u;
#pragma unroll
        for (unsigned j = 0; j < 16; ++j) { const unsigned c = xb_ld(&bar[XB_XCNT(j)]); sum += c; cnt += (c > 0u) ? 1u : 0u; mine = (j == x) ? c : mine; }
        if (sum == G) break;
        __builtin_amdgcn_s_sleep(1);
        if ((++sp & 255u) == 0u) { if (xb_ld(&bar[XB_TMO])) break; if (sp > XB_SPIN_CAP) { atomicAdd(&bar[XB_TMO], 1u); break; } }
    }
    nloc = mine > 0u ? mine : 1u; nx = cnt > 0u ? cnt : 1u;
}

__device__ __forceinline__ void xcd_barrier(const XcdBarrier& b, int tid) {
    asm volatile("s_waitcnt vmcnt(0)" ::: "memory");
    __syncthreads();
    if (tid == 0) {
        unsigned* bar = b.bar; asm volatile("" : "+s"(bar)); unsigned bx = b.x; asm volatile("" : "+s"(bx));
        __builtin_amdgcn_s_waitcnt(0);
        unsigned nloc = b.st[0], nx = b.st[1];
        if (nloc == 0u) { xcd_barrier_complete(bar, bx, nloc, nx); b.st[0] = nloc; b.st[1] = nx; }
        const unsigned old = xb_add(&bar[XB_XSUB(bx)], 1u);
        const unsigned gen = old / nloc;
        if (old + 1u == (gen + 1u) * nloc) {
            __builtin_amdgcn_fence(__ATOMIC_RELEASE, "agent");
            asm volatile("s_waitcnt vmcnt(0)" ::: "memory");
            const unsigned og = xb_add(&bar[XB_TOP], 1u);
            const unsigned tg = og / nx;
            if (og + 1u == (tg + 1u) * nx) xb_add(&bar[XB_TOPGEN], 1u);
            else XB_SPIN(xb_ld(&bar[XB_TOPGEN]) == tg, bar);
            __builtin_amdgcn_fence(__ATOMIC_ACQUIRE, "agent");
            xb_add(&bar[XB_XGEN(bx)], 1u);
            asm volatile("s_waitcnt vmcnt(0)" ::: "memory");
        } else {
            XB_SPIN(xb_ld(&bar[XB_XGEN(bx)]) == gen, bar);
            __builtin_amdgcn_fence(__ATOMIC_ACQUIRE, "agent");
            asm volatile("s_waitcnt vmcnt(0)" ::: "memory");
        }
    }
    __syncthreads();
}

DEV float bf2f(bf16_t v) { return __uint_as_float(((unsigned)v) << 16); }
typedef __bf16 bf16v2 __attribute__((ext_vector_type(2)));
typedef float f32v2 __attribute__((ext_vector_type(2)));
DEV unsigned pkbf(float lo, float hi) { f32v2 v = {lo, hi}; return __builtin_bit_cast(unsigned, __builtin_convertvector(v, bf16v2)); }
DEV bf16_t f2bf(float f) { return (bf16_t)(pkbf(f, 0.f) & 0xffffu); }
DEV unsigned pk2(float lo, float hi) { return pkbf(lo, hi); }
DEV float siluf(float x) { return x * __builtin_amdgcn_rcpf(1.0f + __expf(-x)); }
DEV float sigmf(float x) { return __builtin_amdgcn_rcpf(1.0f + __expf(-x)); }
DEV float softplusf(float x) {
    const float t = __expf(-fabsf(x));
    const float l1p = t < 0.03125f ? t * (1.0f - t * (0.5f - t * (1.0f / 3.0f - 0.25f * t))) : __logf(1.0f + t);
    return fmaxf(x, 0.f) + l1p;
}
template <int CTRL> DEV float dpp_add(float v) {
    const int iv = __float_as_int(v);
    return v + __int_as_float(__builtin_amdgcn_update_dpp(iv, iv, CTRL, 0xF, 0xF, false));
}
DEV float wave_sum(float v) {
    v = dpp_add<0xB1>(v);
    v = dpp_add<0x4E>(v);
    v = dpp_add<0x141>(v);
    v = dpp_add<0x140>(v);
    const int iv = __float_as_int(v);
    return (__int_as_float(__builtin_amdgcn_readlane(iv, 0)) + __int_as_float(__builtin_amdgcn_readlane(iv, 16))) +
           (__int_as_float(__builtin_amdgcn_readlane(iv, 32)) + __int_as_float(__builtin_amdgcn_readlane(iv, 48)));
}
DEV int modrow(int R) { return R < NCR ? NB : (R - NCR) / SQ; }

#define LDS_BARRIER() do { asm volatile("s_waitcnt lgkmcnt(0)" ::: "memory"); __builtin_amdgcn_s_barrier(); asm volatile("" ::: "memory"); } while (0)

DEV void transpose_block(const float* W, int K, int N, bf16_t* WT, int drow0, int k0, int n0, LAS float* tile, int tid) {
    {
        const int kq = tid >> 5, n4 = (tid & 31) * 4;
        const bool ok = n0 + n4 < N;
        const float* src = W + (size_t)(k0 + kq) * N + n0 + n4;
        f32x4 v[8];
#pragma unroll
        for (int i = 0; i < 8; ++i) v[i] = ok ? *(const f32x4*)(src + (size_t)(16 * i) * N) : (f32x4){0.f, 0.f, 0.f, 0.f};
#pragma unroll
        for (int i = 0; i < 8; ++i) { LAS float* d = tile + (16 * i + kq) * 129 + n4; d[0] = v[i].x; d[1] = v[i].y; d[2] = v[i].z; d[3] = v[i].w; }
    }
    LDS_BARRIER();
    {
        const int c = tid & 15;
#pragma unroll
        for (int j = 0; j < 4; ++j) {
            const int n = (tid >> 4) + 32 * j;
            const LAS float* sp = tile + (8 * c) * 129 + n;
            u32x4 o;
            o.x = pk2(sp[0 * 129], sp[1 * 129]); o.y = pk2(sp[2 * 129], sp[3 * 129]); o.z = pk2(sp[4 * 129], sp[5 * 129]); o.w = pk2(sp[6 * 129], sp[7 * 129]);
            *(u32x4*)(WT + (size_t)(drow0 + n) * K + k0 + 8 * c) = o;
        }
    }
    LDS_BARRIER();
}

DEV void ph_prologue(const DParams& p, LAS unsigned char* lds, int wave_s) {
    wave_s = launder_s(wave_s);
    const int tid = get_tid(wave_s), lane = tid & 63, wave = tid >> 6;
    const long gtid = (long)blockIdx.x * NT + tid, gsize = (long)gridDim.x * NT;
    {
        LAS float* cs = (LAS float*)lds;
        LAS float* red = (LAS float*)(lds + 9 * 1024 * 4);
        for (int i = tid; i < 9 * DM; i += NT) { const int r = i / DM, k = i % DM; cs[i] = siluf(r < NB ? p.c[r * DM + k] : lp(p.c_ctx)[k]); }
        LDS_BARRIER();
        for (int task = blockIdx.x; task < 2 * 96; task += gridDim.x) {
            const int l = task / 96, col = (task % 96) * 64 + lane;
            const float* w = lp(p.ada_w) + (size_t)l * DM * NMOD * DM + col;
            float acc[9];
#pragma unroll
            for (int r = 0; r < 9; ++r) acc[r] = 0.f;
#pragma unroll 16
            for (int k = wave * 128; k < wave * 128 + 128; ++k) {
                const float wv = w[(size_t)k * NMOD * DM];
#pragma unroll
                for (int r = 0; r < 9; ++r) acc[r] += cs[r * DM + k] * wv;
            }
#pragma unroll
            for (int r = 0; r < 9; ++r) red[(wave * 9 + r) * 64 + lane] = acc[r];
            LDS_BARRIER();
            for (int i = tid; i < 9 * 64; i += NT) {
                const int r = i / 64, cc = i % 64;
                float s = 0.f;
                for (int w8 = 0; w8 < 8; ++w8) s += red[(w8 * 9 + r) * 64 + cc];
                const int colg = (task % 96) * 64 + cc;
                MOD_(p)[((size_t)l * (NB + 1) + r) * NMOD * DM + colg] = s + lp(p.ada_b)[(size_t)l * NMOD * DM + colg];
            }
            LDS_BARRIER();
        }
    }
    {
        LAS float* tile = (LAS float*)lds;
        unsigned* ctr = (unsigned*)(lp(p.ws) + O_CTR) + 32;
        volatile LAS unsigned* slot = (volatile LAS unsigned*)(lds + LDS_BYTES - 32);
        constexpr int I_IN = 8 * 24, I_OUT = 8 * 8, I_F1 = 8 * 44, I_F2 = 22 * 8, I_L = I_IN + I_OUT + I_F1 + I_F2;
        for (;;) {
            if (tid == 0) slot[0] = atomicAdd(ctr, 1u);
            LDS_BARRIER();
            const int it = (int)slot[0];
            LDS_BARRIER();
            if (it >= 2 * I_L) break;
            const int l = it / I_L; int r = it % I_L;
            if (r < I_IN) { const int kb = r / 24, nb = r % 24; transpose_block(lp(p.w_in) + (size_t)l * DM * INW, DM, INW, WIN_(p) + (size_t)l * NPAD * DM, nb * 128, kb * 128, nb * 128, tile, tid); continue; }
            r -= I_IN;
            if (r < I_OUT) { const int kb = r / 8, nb = r % 8; transpose_block(lp(p.w_out) + (size_t)l * 1024 * DM, 1024, DM, WOUT_(p) + (size_t)l * DM * 1024, nb * 128, kb * 128, nb * 128, tile, tid); continue; }
            r -= I_OUT;
            if (r < I_F1) {
                const int kb = r / 44, nb = r % 44, n0 = nb * 128;
                const int j = n0 < DFF ? n0 : n0 - DFF;
                const int drow = 256 * (j / 128) + (n0 < DFF ? 0 : 128);
                transpose_block(lp(p.w_ffn_in) + (size_t)l * DM * 2 * DFF, DM, 2 * DFF, WF1_(p) + (size_t)l * 2 * DFF * DM, drow, kb * 128, n0, tile, tid); continue;
            }
            r -= I_F1;
            { const int kb = r / 8, nb = r % 8; transpose_block(lp(p.w_ffn_out) + (size_t)l * DFF * DM, DFF, DM, WF2_(p) + (size_t)l * DM * DFF, nb * 128, kb * 128, nb * 128, tile, tid); }
        }
    }
    {
        if (gtid < 16) { const float rate = lp(p.ret_rate)[gtid]; ROPE_(p)[64 * 16 * 2 + gtid] = log1pf(-exp2f(-rate)) * 1.44269504088896f; }
        for (long i = gtid; i < 64 * 16; i += gsize) {
            const int pos = (int)(i / 16), f = (int)(i % 16);
            const double fr = pow(10000.0, -(double)f / 16.0), ang = (double)pos * fr;
            ROPE_(p)[i * 2 + 0] = (float)cos(ang); ROPE_(p)[i * 2 + 1] = (float)sin(ang);
        }
    }
}

DEV void ph_pre0(const DParams& p, LAS unsigned char* lds, int wave_s) {
    wave_s = launder_s(wave_s);
    const int tid = get_tid(wave_s), lane = tid & 63;
    const long gtid = (long)blockIdx.x * NT + tid, gsize = (long)gridDim.x * NT;
    for (long i = gtid; i < 2 * 2 * 9 * DM; i += gsize) {
        const int k = (int)(i % DM), m = (int)((i / DM) % 9), which = (int)((i / (9 * DM)) % 2), l = (int)(i / (2 * 9 * DM));
        const float nw = (which == 0 ? lp(p.norm_mix_w) : lp(p.norm_ffn_w))[l * DM + k];
        const float sc = MOD_(p)[((size_t)l * (NB + 1) + m) * NMOD * DM + (which == 0 ? 1 : 4) * DM + k];
        NWSC_(p)[i] = nw * (1.0f + sc);
    }
    {
        LAS float* shs = (LAS float*)lds;
        for (int vb = blockIdx.x; vb < 256; vb += gridDim.x) {
            const int l = vb >> 7, bb = vb & 127, which = bb < 43 ? 0 : 1, sub = which == 0 ? bb : bb - 43, nsub = which == 0 ? 43 : 85;
            const int N = which == 0 ? NPAD : 2 * DFF;
            const int c0 = (int)((long)N * sub / nsub), c1 = (int)((long)N * (sub + 1) / nsub);
            const bf16_t* Wt = which == 0 ? WIN_(p) + (size_t)l * NPAD * DM : WF1_(p) + (size_t)l * 2 * DFF * DM;
            LDS_BARRIER();
            for (int i = tid; i < 9 * DM; i += NT) shs[i] = MOD_(p)[((size_t)l * (NB + 1) + i / DM) * NMOD * DM + (which == 0 ? 0 : 3) * DM + (i % DM)];
            LDS_BARRIER();
            float sh[9][16];
#pragma unroll
            for (int m = 0; m < 9; ++m)
#pragma unroll
                for (int q = 0; q < 4; ++q) {
                    const f32x4 t4 = *(const LAS f32x4*)(shs + m * DM + (q >> 1) * 512 + 8 * lane + 4 * (q & 1));
                    sh[m][4 * q + 0] = t4.x; sh[m][4 * q + 1] = t4.y; sh[m][4 * q + 2] = t4.z; sh[m][4 * q + 3] = t4.w;
                }
            float* bo = BIAS_(p) + ((size_t)l * 2 + which) * 9 * 5632;
            for (int n = c0 + wave_s; n < c1; n += NW) {
                const u32x4 w0 = *(const u32x4*)(Wt + (size_t)n * DM + 8 * lane), w1 = *(const u32x4*)(Wt + (size_t)n * DM + 512 + 8 * lane);
                float wv[16];
#pragma unroll
                for (int j = 0; j < 4; ++j) { wv[2 * j] = __uint_as_float(w0[j] << 16); wv[2 * j + 1] = __uint_as_float(w0[j] & 0xffff0000u); wv[8 + 2 * j] = __uint_as_float(w1[j] << 16); wv[8 + 2 * j + 1] = __uint_as_float(w1[j] & 0xffff0000u); }
                float acc[9];
#pragma unroll
                for (int m = 0; m < 9; ++m) {
                    float a = 0.f;
#pragma unroll
                    for (int j = 0; j < 16; ++j) a += sh[m][j] * wv[j];
                    acc[m] = wave_sum(a);
                }
                if (lane < 9) {
                    float v = acc[0];
#pragma unroll
                    for (int m = 1; m < 9; ++m) v = lane == m ? acc[m] : v;
                    bo[(size_t)lane * 5632 + n] = v;
                }
            }
        }
        LDS_BARRIER();
    }
    {
        const int gw = blockIdx.x * NW + wave_s, ngw = gridDim.x * NW;
        const float* nw = lp(p.norm_mix_w);
        for (int R = gw; R < ROWS; R += ngw) {
            const f32x4* xr = (const f32x4*)(R < NCR ? lp(p.ctx) + (size_t)R * DM : lp(p.x) + (size_t)(R - NCR) * DM) + lane;
            f32x4 v[4]; float sq = 0.f;
#pragma unroll
            for (int j = 0; j < 4; ++j) { v[j] = xr[64 * j]; sq += (v[j].x * v[j].x + v[j].y * v[j].y) + (v[j].z * v[j].z + v[j].w * v[j].w); }
            sq = wave_sum(sq);
            const f32x4* sc = (const f32x4*)(MOD_(p) + (size_t)modrow(R) * NMOD * DM + 1 * DM) + lane;
            const f32x4* w4 = (const f32x4*)nw + lane;
            unsigned long long* o8 = (unsigned long long*)(H_(p) + (size_t)R * DM) + lane;
#pragma unroll
            for (int j = 0; j < 4; ++j) {
                const f32x4 a = v[j] * w4[64 * j] * (sc[64 * j] + 1.0f);
                o8[64 * j] = (unsigned long long)pk2(a.x, a.y) | ((unsigned long long)pk2(a.z, a.w) << 32);
            }
            if (lane < 16) SSQ_(p)[(size_t)R * 16 + lane] = lane == 0 ? sq : 0.f;
        }
    }
}

DEV float shfl_xor_l(float v, int m) { return __int_as_float(__builtin_amdgcn_ds_bpermute((lane_id() ^ m) << 2, __float_as_int(v))); }
DEV void rows_rstd(const float* ssq, int R0, int fq, float (&rs)[2][4]) {
    f32x4 q[2][4];
#pragma unroll
    for (int ai = 0; ai < 2; ++ai)
#pragma unroll
        for (int m = 0; m < 4; ++m) q[ai][m] = *(const f32x4*)(ssq + (size_t)(R0 + ai * 128 + m * 16) * 16 + 4 * fq);
#pragma unroll
    for (int ai = 0; ai < 2; ++ai)
#pragma unroll
        for (int m = 0; m < 4; ++m) {
            float a = (q[ai][m].x + q[ai][m].y) + (q[ai][m].z + q[ai][m].w);
            a += shfl_xor_l(a, 16); a += shfl_xor_l(a, 32);
            rs[ai][m] = __builtin_amdgcn_rsqf(a * (1.0f / DM) + 1e-6f);
        }
}
struct EpiP {
    static constexpr bool PERM = true, AFTER_DRAIN = false;
    bf16_t* O; int ldc; const float* ssq; const float* bias;
    DEV void operator()(const f32x4 (&acc)[2][2][4][2], const Unit& u, int wr, int wc, int fr, int fq) const {
        const int row0 = u.pm * 256 + wr * 64 + fr, col0 = u.pn * 256 + wc * 32 + 8 * fq;
        const float* bp = bias + (size_t)modrow(u.pm * 256) * 5632 + col0;
        f32x4 bv[2][2];
#pragma unroll
        for (int bj = 0; bj < 2; ++bj)
#pragma unroll
            for (int n = 0; n < 2; ++n) bv[bj][n] = *(const f32x4*)(bp + bj * 128 + 4 * n);
        float rs[2][4];
        rows_rstd(ssq, row0, fq, rs);
#pragma unroll
        for (int ai = 0; ai < 2; ++ai)
#pragma unroll
            for (int m = 0; m < 4; ++m) {
                bf16_t* rowp = O + (size_t)(row0 + ai * 128 + m * 16) * ldc + col0;
#pragma unroll
                for (int bj = 0; bj < 2; ++bj) {
                    const f32x4 v0 = acc[ai][bj][m][0] * rs[ai][m] + bv[bj][0], v1 = acc[ai][bj][m][1] * rs[ai][m] + bv[bj][1];
                    u32x4 w; w.x = pg8::cvt_pk_bf16(v0[0], v0[1]); w.y = pg8::cvt_pk_bf16(v0[2], v0[3]); w.z = pg8::cvt_pk_bf16(v1[0], v1[1]); w.w = pg8::cvt_pk_bf16(v1[2], v1[3]);
                    if (col0 + bj * 128 < INW) *(u32x4*)(rowp + bj * 128) = w;
                }
            }
    }
};
struct EpiSwiglu {
    static constexpr bool PERM = true, AFTER_DRAIN = false;
    bf16_t* O; int ldc; const float* ssq; const float* bias; int row_base;
    DEV void operator()(const f32x4 (&acc)[2][2][4][2], const Unit& u, int wr, int wc, int fr, int fq) const {
        const int row0 = u.pm * 256 + wr * 64 + fr, col0 = u.pn * 128 + wc * 32 + 8 * fq;
        const float* bp = bias + (size_t)modrow(row_base + u.pm * 256) * 5632 + u.pn * 256 + wc * 32 + 8 * fq;
        f32x4 bg[2], bu[2];
#pragma unroll
        for (int n = 0; n < 2; ++n) { bg[n] = *(const f32x4*)(bp + 4 * n); bu[n] = *(const f32x4*)(bp + 128 + 4 * n); }
        float rs[2][4];
        rows_rstd(ssq, row_base + row0, fq, rs);
#pragma unroll
        for (int ai = 0; ai < 2; ++ai)
#pragma unroll
            for (int m = 0; m < 4; ++m) {
                bf16_t* rowp = O + (size_t)(row0 + ai * 128 + m * 16) * ldc + col0;
                float v[8];
#pragma unroll
                for (int n = 0; n < 2; ++n)
#pragma unroll
                    for (int i = 0; i < 4; ++i) { const float g = acc[ai][0][m][n][i] * rs[ai][m] + bg[n][i], up = acc[ai][1][m][n][i] * rs[ai][m] + bu[n][i]; v[n * 4 + i] = g * __builtin_amdgcn_rcpf(1.0f + __expf(-g)) * up; }
                u32x4 w; w.x = pg8::cvt_pk_bf16(v[0], v[1]); w.y = pg8::cvt_pk_bf16(v[2], v[3]); w.z = pg8::cvt_pk_bf16(v[4], v[5]); w.w = pg8::cvt_pk_bf16(v[6], v[7]);
                *(u32x4*)rowp = w;
            }
    }
};
struct EpiRes {
    static constexpr bool PERM = true, AFTER_DRAIN = false;
    const float* SL; const float* SC; float* XL; float* XC; const float* modl; int gidx; int row_base;
    const float* nwsc;
    bf16_t* An;
    float* ssq;
    DEV void operator()(const f32x4 (&acc)[2][2][4][2], const Unit& u, int wr, int wc, int fr, int fq) const {
        const int row0 = row_base + u.pm * 256 + wr * 64 + fr, col0 = u.pn * 256 + wc * 32 + 8 * fq;
        const int mr = modrow(row_base + u.pm * 256);
        const float* g = modl + (size_t)mr * NMOD * DM + gidx * DM + col0;
        const bool isc = (row_base + u.pm * 256) < NCR;
        const size_t xb = (isc ? (size_t)row0 * DM : (size_t)(row0 - NCR) * DM) + col0;
        const float* xs = (isc ? SC : SL) + xb;
        float* xd = (isc ? XC : XL) + xb;
        f32x4 gv[2][2], nv[2][2];
#pragma unroll
        for (int bj = 0; bj < 2; ++bj)
#pragma unroll
            for (int n = 0; n < 2; ++n) {
                gv[bj][n] = *(const f32x4*)(g + bj * 128 + n * 4);
                nv[bj][n] = nwsc ? *(const f32x4*)(nwsc + (size_t)mr * DM + col0 + bj * 128 + n * 4) : (f32x4){0.f, 0.f, 0.f, 0.f};
            }
#pragma unroll
        for (int am = 0; am < 4; ++am) {
            const int ai = am >> 1, m0 = (am & 1) * 2;
            f32x4 xo[2][2][2];
#pragma unroll
            for (int mm = 0; mm < 2; ++mm)
#pragma unroll
                for (int bj = 0; bj < 2; ++bj)
#pragma unroll
                    for (int n = 0; n < 2; ++n) xo[mm][bj][n] = *(const f32x4*)(xs + (size_t)(ai * 128 + (m0 + mm) * 16) * DM + bj * 128 + n * 4);
            asm volatile("" ::: "memory");
#pragma unroll
            for (int mm = 0; mm < 2; ++mm) {
                const int m = m0 + mm;
                const int R = row0 + ai * 128 + m * 16;
                const size_t ro = (size_t)(ai * 128 + m * 16) * DM;
                float sq = 0.f;
#pragma unroll
                for (int bj = 0; bj < 2; ++bj) {
                    const f32x4 x0 = xo[mm][bj][0] + gv[bj][0] * acc[ai][bj][m][0], x1 = xo[mm][bj][1] + gv[bj][1] * acc[ai][bj][m][1];
                    *(f32x4*)(xd + ro + bj * 128) = x0; *(f32x4*)(xd + ro + bj * 128 + 4) = x1;
                    sq += ((x0.x * x0.x + x0.y * x0.y) + (x0.z * x0.z + x0.w * x0.w)) + ((x1.x * x1.x + x1.y * x1.y) + (x1.z * x1.z + x1.w * x1.w));
                    if (nwsc) {
                        const f32x4 a0 = x0 * nv[bj][0], a1 = x1 * nv[bj][1];
                        u32x4 w; w.x = pg8::cvt_pk_bf16(a0.x, a0.y); w.y = pg8::cvt_pk_bf16(a0.z, a0.w); w.z = pg8::cvt_pk_bf16(a1.x, a1.y); w.w = pg8::cvt_pk_bf16(a1.z, a1.w);
                        *(u32x4*)(An + (size_t)R * DM + col0 + bj * 128) = w;
                    }
                }
                sq += shfl_xor_l(sq, 16); sq += shfl_xor_l(sq, 32);
                if (fq == 0) ssq[(size_t)R * 16 + u.pn * 4 + wc] = sq;
            }
        }
    }
};

typedef float f32x16 __attribute__((ext_vector_type(16)));
using pg8::bf16x8;
#define MFMA32(a, b, c) __builtin_amdgcn_mfma_f32_32x32x16_bf16((a), (b), (c), 0, 0, 0)
DEV float bflo(unsigned w) { return __uint_as_float(w << 16); }
DEV float bfhi(unsigned w) { return __uint_as_float(w & 0xffff0000u); }
DEV float xor32_max(float v) { const auto r = __builtin_amdgcn_permlane32_swap(__float_as_uint(v), __float_as_uint(v), false, false); return fmaxf(__uint_as_float(r[0]), __uint_as_float(r[1])); }
DEV float xor32_sum(float v) { const auto r = __builtin_amdgcn_permlane32_swap(__float_as_uint(v), __float_as_uint(v), false, false); return __uint_as_float(r[0]) + __uint_as_float(r[1]); }
DEV float shfl_xor32(float v) { const int idx = (lane_id() ^ 32) << 2; return __int_as_float(__builtin_amdgcn_ds_bpermute(idx, __float_as_int(v))); }
DEV int kswz(int r) { return (r & ~12) | ((r & 4) << 1) | ((r & 8) >> 1); }

DEV void swa_unit(const DParams& p, int layer, int unit, LAS unsigned char* lds, int tid, int wave_s) {
    const bool lat = unit < NB * 2 * 64;
    int b, kvh, qb;
    if (lat) { b = unit / 128; kvh = (unit / 64) & 1; qb = unit % 64; }
    else { const int u = unit - NB * 2 * 64; b = u / 8; kvh = (u / 4) & 1; qb = u % 4; }
    const int lt_lo = lat ? (qb - 2 < 0 ? 0 : qb - 2) : 0, lt_hi = lat ? (qb + 2 > 63 ? 63 : qb + 2) : -1;
    const int nt = 4 + (lt_hi - lt_lo + 1);
    {
        const bf16_t* kt = KT_(p) + (size_t)(b * 2 + kvh) * 68 * 4096;
        const bf16_t* vt = VT_(p) + (size_t)(b * 2 + kvh) * 68 * 4096;
        for (int i = 0; i < nt; ++i) {
            const int tile = i < 4 ? i : 4 + lt_lo + (i - 4);
            const u32x4 kq = *(const u32x4*)(kt + (size_t)tile * 4096 + tid * 8);
            const u32x4 vq = *(const u32x4*)(vt + (size_t)tile * 4096 + tid * 8);
            *(LAS u32x4*)(lds + i * 16384 + tid * 16) = kq;
            *(LAS u32x4*)(lds + i * 16384 + 8192 + tid * 16) = vq;
        }
    }
    LDS_BARRIER();
    const int lane = tid & 63, r = lane & 31, h = lane >> 5;
    const int g = wave_s >> 1, sb = wave_s & 1, hq = kvh * 4 + g;
    const int qloc = qb * 64 + 32 * sb + r;
    const int qrow = lat ? NCR + b * SQ + qloc : b * CTX + qloc;
    bf16x8 qf[4];
    {
        const bf16_t* qp = P_(p) + (size_t)qrow * PST + C_SQ + hq * 64 + 8 * h;
        float qv[4][8];
#pragma unroll
        for (int s4 = 0; s4 < 4; ++s4) {
            const u32x4 w = *(const u32x4*)(qp + 16 * s4);
#pragma unroll
            for (int j = 0; j < 8; ++j) qv[s4][j] = (j & 1) ? bfhi(w[j >> 1]) : bflo(w[j >> 1]);
        }
        if (lat) {
#pragma unroll
            for (int a = 0; a < 2; ++a) {
                const int pos = a == 0 ? qloc / 64 : qloc % 64;
                const float* rp = ROPE_(p) + (pos * 16 + 8 * h) * 2;
#pragma unroll
                for (int j = 0; j < 8; ++j) {
                    const float cs = rp[2 * j], sn = rp[2 * j + 1], t1 = qv[2 * a][j], t2 = qv[2 * a + 1][j];
                    qv[2 * a][j] = t1 * cs - t2 * sn; qv[2 * a + 1][j] = t1 * sn + t2 * cs;
                }
            }
        }
        const float qs = 0.125f * 1.44269504088896f;
#pragma unroll
        for (int s4 = 0; s4 < 4; ++s4) {
            u32x4 w;
            w.x = pkbf(qv[s4][0] * qs, qv[s4][1] * qs); w.y = pkbf(qv[s4][2] * qs, qv[s4][3] * qs);
            w.z = pkbf(qv[s4][4] * qs, qv[s4][5] * qs); w.w = pkbf(qv[s4][6] * qs, qv[s4][7] * qs);
            qf[s4] = __builtin_bit_cast(bf16x8, w);
        }
    }
    f32x16 O0, O1;
#pragma unroll
    for (int i = 0; i < 16; ++i) { O0[i] = 0.f; O1[i] = 0.f; }
    float m = lp(p.swa_sinks)[layer * 8 + hq] * 1.44269504088896f, l = 1.0f;
    const int ksw = ((r >> 1) & 7);
    for (int ti = 0; ti < nt; ++ti) {
        const LAS unsigned char* Kt = lds + ti * 16384;
        const LAS unsigned char* Vt = Kt + 8192;
        f32x16 x0, x1;
#pragma unroll
        for (int i = 0; i < 16; ++i) { x0[i] = 0.f; x1[i] = 0.f; }
#pragma unroll
        for (int s4 = 0; s4 < 4; ++s4) {
            const bf16x8 k0 = *(const LAS bf16x8*)(Kt + r * 128 + (((2 * s4 + h) ^ ksw) * 16));
            const bf16x8 k1 = *(const LAS bf16x8*)(Kt + (32 + r) * 128 + (((2 * s4 + h) ^ ksw) * 16));
            x0 = MFMA32(k0, qf[s4], x0);
            x1 = MFMA32(k1, qf[s4], x1);
        }
        if (ti >= 4) {
            const int lt = lt_lo + (ti - 4);
            if (lt == qb - 2 || lt == qb + 2) {
                const int kbase = lt * 64 + 4 * h - qloc;
#pragma unroll
                for (int i = 0; i < 16; ++i) {
                    const int d0 = kbase + (i & 3) + 8 * (i >> 2), d1 = d0 + 32;
                    if (d0 > 128 || d0 < -128) x0[i] = -1e30f;
                    if (d1 > 128 || d1 < -128) x1[i] = -1e30f;
                }
            }
        }
        float mx = x0[0];
#pragma unroll
        for (int i = 1; i < 16; ++i) mx = fmaxf(mx, x0[i]);
#pragma unroll
        for (int i = 0; i < 16; ++i) mx = fmaxf(mx, x1[i]);
        mx = xor32_max(mx);
        const float mn = fmaxf(m, mx), alpha = __builtin_amdgcn_exp2f(m - mn);
        m = mn;
        float rs = 0.f;
#pragma unroll
        for (int i = 0; i < 16; ++i) { x0[i] = __builtin_amdgcn_exp2f(x0[i] - mn); x1[i] = __builtin_amdgcn_exp2f(x1[i] - mn); rs += x0[i] + x1[i]; }
        rs = xor32_sum(rs);
        l = l * alpha + rs;
#pragma unroll
        for (int i = 0; i < 16; ++i) { O0[i] *= alpha; O1[i] *= alpha; }
#pragma unroll
        for (int kg = 0; kg < 2; ++kg)
#pragma unroll
            for (int s2 = 0; s2 < 2; ++s2) {
                u32x4 w;
                if (kg == 0) { w.x = pkbf(x0[8 * s2 + 0], x0[8 * s2 + 1]); w.y = pkbf(x0[8 * s2 + 2], x0[8 * s2 + 3]); w.z = pkbf(x0[8 * s2 + 4], x0[8 * s2 + 5]); w.w = pkbf(x0[8 * s2 + 6], x0[8 * s2 + 7]); }
                else { w.x = pkbf(x1[8 * s2 + 0], x1[8 * s2 + 1]); w.y = pkbf(x1[8 * s2 + 2], x1[8 * s2 + 3]); w.z = pkbf(x1[8 * s2 + 4], x1[8 * s2 + 5]); w.w = pkbf(x1[8 * s2 + 6], x1[8 * s2 + 7]); }
                const bf16x8 pf = __builtin_bit_cast(bf16x8, w);
                const int ch = 4 * kg + 2 * s2 + h;
                const bf16x8 v0 = *(const LAS bf16x8*)(Vt + r * 128 + ((ch ^ ksw) * 16));
                const bf16x8 v1 = *(const LAS bf16x8*)(Vt + (32 + r) * 128 + ((ch ^ ksw) * 16));
                O0 = MFMA32(v0, pf, O0);
                O1 = MFMA32(v1, pf, O1);
            }
    }
    {
        const float inv = 1.0f / l;
        bf16_t* op = H_(p) + (size_t)qrow * 1024 + 256 + hq * 64 + 4 * h;
#pragma unroll
        for (int g4 = 0; g4 < 4; ++g4) {
            uint2 w0, w1;
            w0.x = pkbf(O0[4 * g4] * inv, O0[4 * g4 + 1] * inv); w0.y = pkbf(O0[4 * g4 + 2] * inv, O0[4 * g4 + 3] * inv);
            w1.x = pkbf(O1[4 * g4] * inv, O1[4 * g4 + 1] * inv); w1.y = pkbf(O1[4 * g4 + 2] * inv, O1[4 * g4 + 3] * inv);
            *(uint2*)(op + 8 * g4) = w0;
            *(uint2*)(op + 32 + 8 * g4) = w1;
        }
    }
    LDS_BARRIER();
}

typedef float f32x4v __attribute__((ext_vector_type(4)));
#define MFMA16(a, b, c) __builtin_amdgcn_mfma_f32_16x16x32_bf16((a), (b), (c), 0, 0, 0)
DEV float ex2(float x) { return __builtin_amdgcn_exp2f(x); }
template <int CTRL> DEV float dpp_mov(float v) { const int iv = __float_as_int(v); return __int_as_float(__builtin_amdgcn_update_dpp(iv, iv, CTRL, 0xF, 0xF, false)); }
DEV float row16_sum(float v) {
    v += dpp_mov<0xB1>(v); v += dpp_mov<0x4E>(v); v += dpp_mov<0x141>(v); v += dpp_mov<0x140>(v); return v;
}
DEV int chunk_row0(int b, int n) { return n < 4 ? b * CTX + n * 64 : NCR + b * SQ + (n - 4) * 64; }
DEV void load_rope8(const DParams& p, const bf16_t* hp, int c, bool lat, int t, float scale, float (&o)[8]) {
    const u32x4 kv = *(const u32x4*)(hp + 8 * c);
#pragma unroll
    for (int j = 0; j < 8; ++j) o[j] = (j & 1) ? bfhi(kv[j >> 1]) : bflo(kv[j >> 1]);
    if (lat) {
        const u32x4 pv = *(const u32x4*)(hp + 8 * (c ^ 2));
        const int pos = (c >> 2) == 0 ? t / 64 : t % 64;
        const float* rp = ROPE_(p) + (pos * 16 + 8 * (c & 1)) * 2;
        const bool first = (c & 2) == 0;
        f32x4 rt[4];
#pragma unroll
        for (int q4 = 0; q4 < 4; ++q4) rt[q4] = *(const f32x4*)(rp + 4 * q4);
#pragma unroll
        for (int j = 0; j < 8; ++j) {
            const float oth = (j & 1) ? bfhi(pv[j >> 1]) : bflo(pv[j >> 1]);
            const float cs = rt[j >> 1][2 * (j & 1)], sn = rt[j >> 1][2 * (j & 1) + 1];
            o[j] = first ? o[j] * cs - oth * sn : oth * sn + o[j] * cs;
        }
    }
#pragma unroll
    for (int j = 0; j < 8; ++j) o[j] *= scale;
}
DEV u32x4 pack8(const float (&o)[8]) { u32x4 w; w.x = pkbf(o[0], o[1]); w.y = pkbf(o[2], o[3]); w.z = pkbf(o[4], o[5]); w.w = pkbf(o[6], o[7]); return w; }

DEV float ret_lg2(const DParams& p, int layer, int dir, int h) { return ROPE_(p)[64 * 16 * 2 + layer * 8 + dir * 4 + h]; }
struct RetOps { u32x4 kw[2]; bf16x8 bq[2][2]; };
DEV int chain_chunk(int dir, int step) { return dir == 0 ? step : (step < 4 ? 3 - step : 67 - (step - 4)); }
DEV void ret_ops_load(RetOps& o, const bf16_t* rkt, const bf16_t* rvt, int bh, int dir, int step, int it, int jt0, int lr, int lq) {
    const size_t rec = (size_t)bh * 68 + chain_chunk(dir, step);
#pragma unroll
    for (int ks = 0; ks < 2; ++ks) {
        o.kw[ks] = *(const u32x4*)(rkt + rec * 4096 + (16 * it + lr) * 64 + 32 * ks + 8 * lq);
#pragma unroll
        for (int t = 0; t < 2; ++t) o.bq[t][ks] = *(const bf16x8*)(rvt + rec * 4096 + (16 * (jt0 + t) + lr) * 64 + 32 * ks + 8 * lq);
    }
}
DEV void ret_scan_chain(const DParams& p, int layer, int chain, int tid, int wave_s) {
    const int dir = chain & 1, bh = chain >> 1, h = bh & 3;
    const int lane = tid & 63, lr = lane & 15, lq = lane >> 4, it = wave_s >> 1, jt0 = 2 * (wave_s & 1);
    const float lg2 = ret_lg2(p, layer, dir, h), g64 = ex2(64.f * lg2);
    float dec[2][8];
#pragma unroll
    for (int ks = 0; ks < 2; ++ks)
#pragma unroll
        for (int j = 0; j < 8; ++j) { const int tok = 32 * ks + 8 * lq + j; dec[ks][j] = ex2(lg2 * (float)(dir == 0 ? 63 - tok : tok)); }
    const bf16_t* rkt = RKT_(p); const bf16_t* rvt = RVT_(p); bf16_t* rst = RST_(p);
    f32x4v S[2];
#pragma unroll
    for (int t = 0; t < 2; ++t) S[t] = (f32x4v){0.f, 0.f, 0.f, 0.f};
    RetOps o0, o1, o2, o3;
    ret_ops_load(o0, rkt, rvt, bh, dir, 0, it, jt0, lr, lq); ret_ops_load(o1, rkt, rvt, bh, dir, 1, it, jt0, lr, lq);
    ret_ops_load(o2, rkt, rvt, bh, dir, 2, it, jt0, lr, lq); ret_ops_load(o3, rkt, rvt, bh, dir, 3, it, jt0, lr, lq);
#define RET_STEP(O, STEP) do { \
        const size_t srec = (size_t)chain * 68 + chain_chunk(dir, (STEP)); \
        _Pragma("unroll") for (int t = 0; t < 2; ++t) { u32x2 w; w.x = pkbf(S[t][0], S[t][1]); w.y = pkbf(S[t][2], S[t][3]); \
            *(u32x2*)(rst + srec * 4096 + (16 * (jt0 + t) + lr) * 64 + 16 * it + 4 * lq) = w; } \
        bf16x8 a_[2]; \
        _Pragma("unroll") for (int ks = 0; ks < 2; ++ks) { float kv[8]; \
            _Pragma("unroll") for (int j = 0; j < 8; ++j) kv[j] = ((j & 1) ? bfhi(O.kw[ks][j >> 1]) : bflo(O.kw[ks][j >> 1])) * dec[ks][j]; \
            a_[ks] = __builtin_bit_cast(bf16x8, pack8(kv)); } \
        _Pragma("unroll") for (int t = 0; t < 2; ++t) { S[t] = S[t] * g64; \
            _Pragma("unroll") for (int ks = 0; ks < 2; ++ks) S[t] = MFMA16(a_[ks], O.bq[t][ks], S[t]); } \
        if ((STEP) + 4 < 68) ret_ops_load(O, rkt, rvt, bh, dir, (STEP) + 4, it, jt0, lr, lq); \
    } while (0)
#pragma unroll
    for (int step = 0; step < 68; step += 4) { RET_STEP(o0, step); RET_STEP(o1, step + 1); RET_STEP(o2, step + 2); RET_STEP(o3, step + 3); }
#undef RET_STEP
}

DEV void gdn_conv8(const float* cw, const bf16_t* hp, int chan, bool hasp, bool hasn, float (&o)[8]) {
    const u32x4 cur = *(const u32x4*)hp;
    u32x4 prv = (u32x4){0u, 0u, 0u, 0u}, nxt = prv;
    if (hasp) prv = *(const u32x4*)(hp - PST);
    if (hasn) nxt = *(const u32x4*)(hp + PST);
    f32x4 w[3][2];
#pragma unroll
    for (int t3 = 0; t3 < 3; ++t3) { w[t3][0] = *(const f32x4*)(cw + t3 * 768 + chan); w[t3][1] = *(const f32x4*)(cw + t3 * 768 + chan + 4); }
#pragma unroll
    for (int j = 0; j < 8; ++j) {
        const float a = ((j & 1) ? bfhi(prv[j >> 1]) : bflo(prv[j >> 1])) * w[0][j >> 2][j & 3] + ((j & 1) ? bfhi(cur[j >> 1]) : bflo(cur[j >> 1])) * w[1][j >> 2][j & 3] +
                        ((j & 1) ? bfhi(nxt[j >> 1]) : bflo(nxt[j >> 1])) * w[2][j >> 2][j & 3];
        o[j] = a * __builtin_amdgcn_rcpf(1.0f + __expf(-a));
    }
}
DEV float oct_sum(float v) { v += dpp_mov<0xB1>(v); v += dpp_mov<0x4E>(v); v += dpp_mov<0x141>(v); return v; }
DEV void l2norm8(float (&o)[8], float extra) {
    float ss = 0.f;
#pragma unroll
    for (int j = 0; j < 8; ++j) ss += o[j] * o[j];
    const float sc = extra * __builtin_amdgcn_rsqf(oct_sum(ss) + 1e-6f);
#pragma unroll
    for (int j = 0; j < 8; ++j) o[j] *= sc;
}


struct GdnPre { u32x4 kc[3], vc[3]; float ga, gb; };
DEV void gdn_pre_load(GdnPre& o, const DParams& p, int task, int tid) {
    const int n = task % 68, bh = task / 68, b = bh >> 2, h = bh & 3;
    const int row0 = chunk_row0(b, n), r = tid >> 3, c = tid & 7;
    const int slen = n < 4 ? CTX : SQ, t0 = n < 4 ? n * 64 : (n - 4) * 64;
    const bf16_t* prow = P_(p) + (size_t)(row0 + r) * PST;
    const bool hasp = t0 + r > 0, hasn = t0 + r + 1 < slen;
    const u32x4 z = (u32x4){0u, 0u, 0u, 0u};
    const bf16_t* kp = prow + C_GK + h * 64 + 8 * c;
    const bf16_t* vp = prow + C_GV + h * 64 + 8 * c;
    o.kc[1] = *(const u32x4*)kp; o.vc[1] = *(const u32x4*)vp;
    o.kc[0] = z; o.vc[0] = z; o.kc[2] = z; o.vc[2] = z;
    if (hasp) { o.kc[0] = *(const u32x4*)(kp - PST); o.vc[0] = *(const u32x4*)(vp - PST); }
    if (hasn) { o.kc[2] = *(const u32x4*)(kp + PST); o.vc[2] = *(const u32x4*)(vp + PST); }
    o.ga = 0.f; o.gb = 0.f;
    if (tid < 128) {
        const int dir = tid >> 6, i = tid & 63;
        const bf16_t* pr = P_(p) + (size_t)(row0 + i) * PST;
        o.ga = bf2f(pr[C_GA + dir * 4 + h]); o.gb = bf2f(pr[C_GB + dir * 4 + h]);
    }
}
DEV void conv8_regs(const float* cw, const u32x4 (&x)[3], int chan, float (&o)[8]) {
    f32x4 w[3][2];
#pragma unroll
    for (int t3 = 0; t3 < 3; ++t3) { w[t3][0] = *(const f32x4*)(cw + t3 * 768 + chan); w[t3][1] = *(const f32x4*)(cw + t3 * 768 + chan + 4); }
#pragma unroll
    for (int j = 0; j < 8; ++j) {
        const float a = ((j & 1) ? bfhi(x[0][j >> 1]) : bflo(x[0][j >> 1])) * w[0][j >> 2][j & 3] + ((j & 1) ? bfhi(x[1][j >> 1]) : bflo(x[1][j >> 1])) * w[1][j >> 2][j & 3] +
                        ((j & 1) ? bfhi(x[2][j >> 1]) : bflo(x[2][j >> 1])) * w[2][j >> 2][j & 3];
        o[j] = a * __builtin_amdgcn_rcpf(1.0f + __expf(-a));
    }
}
DEV float shfl_lane(float v, int src) { return __int_as_float(__builtin_amdgcn_ds_bpermute(src << 2, __float_as_int(v))); }

DEV void gdn_prep_task(const DParams& p, int layer, int task, int next_task, GdnPre& pre, LAS unsigned char* lds, int tid, int wave_s) {
    const int n = task % 68, bh = task / 68, h = bh & 3;
    const int r = tid >> 3, c = tid & 7;
    LAS bf16_t* kk = (LAS bf16_t*)lds;
    LAS bf16_t* kT = kk + 64 * 72;
    LAS bf16_t* vv = kT + 64 * 72;
    constexpr int MS = 65, XS = 129;
    LAS float* M0 = (LAS float*)(vv + 64 * 72);
    LAS float* M1 = M0 + 64 * MS;
    LAS float* gs = M1 + 64 * MS;
    LAS float* xs = gs + 640;
    const float* cw = lp(p.gdn_conv_w) + (size_t)layer * 3 * 768;
    const int lane = tid & 63, lr = lane & 15, lq = lane >> 4;
    {
        float o[8];
        conv8_regs(cw, pre.kc, 256 + h * 64 + 8 * c, o);
        l2norm8(o, 1.0f);
        *(LAS u32x4*)(kk + r * 72 + 8 * c) = pack8(o);
#pragma unroll
        for (int j = 0; j < 8; ++j) kT[(8 * c + j) * 72 + (r ^ (8 * c))] = f2bf(o[j]);
        conv8_regs(cw, pre.vc, 512 + h * 64 + 8 * c, o);
        *(LAS u32x4*)(vv + r * 72 + 8 * c) = pack8(o);
        if (tid < 128) {
            const int dir = wave_s;
            const float arate = __expf(lp(p.gdn_a_log)[layer * 8 + dir * 4 + h]), dtb = lp(p.gdn_dt_bias)[layer * 8 + dir * 4 + h];
            const float g = -arate * softplusf(pre.ga + dtb), bt = sigmf(pre.gb);
            float v = shfl_lane(g, dir ? 63 - lane : lane);
            const int lid = lane_id();
#pragma unroll
            for (int off = 1; off < 64; off <<= 1) { const float t = shfl_lane(v, lid - off); if (lid >= off) v += t; }
            const float gc = shfl_lane(v, dir ? 63 - lane : lane);
            gs[128 + dir * 64 + lane] = bt; gs[256 + dir * 64 + lane] = gc;
            gs[384 + dir * 128 + lane] = bt; gs[384 + dir * 128 + 64 + lane] = bt * __expf(gc);
        }
    }
    if (next_task >= 0) gdn_pre_load(pre, p, next_task, tid);
    LDS_BARRIER();
#pragma unroll
    for (int tt = 0; tt < 2; ++tt) {
        const int t = 2 * wave_s + tt, it = t >> 2, jt = t & 3;
        f32x4v acc = (f32x4v){0.f, 0.f, 0.f, 0.f};
#pragma unroll
        for (int ks = 0; ks < 2; ++ks)
            acc = MFMA16(*(const LAS bf16x8*)(kk + (16 * it + lr) * 72 + 32 * ks + 8 * lq), *(const LAS bf16x8*)(kk + (16 * jt + lr) * 72 + 32 * ks + 8 * lq), acc);
#pragma unroll
        for (int rg = 0; rg < 4; ++rg) {
            const int i = 16 * it + 4 * lq + rg, j = 16 * jt + lr;
            if (i > j) M0[j * MS + i] = -gs[128 + i] * acc[rg] * __expf(gs[256 + i] - gs[256 + j]);
            if (i < j) M1[(63 - j) * MS + (63 - i)] = -gs[192 + i] * acc[rg] * __expf(gs[320 + i] - gs[320 + j]);
        }
    }
    LDS_BARRIER();
#define MFMA4F(a, b, c) __builtin_amdgcn_mfma_f32_16x16x4f32((a), (b), (c), 0, 0, 0)
    LAS float* DI = xs + 2 * 64 * XS;
    {
        const int d = wave_s >> 2, B = wave_s & 3;
        const LAS float* Mb = (d ? M1 : M0) + (16 * B) * MS + 16 * B;
        f32x4v PU, QU, EY;
        {
#pragma unroll
            for (int rg = 0; rg < 4; ++rg) {
                const int kx = 4 * lq + rg;
                const float pv = Mb[kx * MS + lr], qv = Mb[lr * MS + kx];
                QU[rg] = kx > lr ? qv : 0.f;
                PU[rg] = lr > kx ? pv : 0.f;
                EY[rg] = kx == lr ? 1.f : 0.f;
            }
        }
        const f32x4v Z4 = (f32x4v){0.f, 0.f, 0.f, 0.f};
        f32x4v PU2 = Z4, QU2 = Z4, PU4 = Z4, QU4 = Z4, QU8 = Z4, T1 = Z4, T2 = Z4, T3 = Z4;
#pragma unroll
        for (int rg = 0; rg < 4; ++rg) { PU2 = MFMA4F(QU[rg], PU[rg], PU2); QU2 = MFMA4F(PU[rg], QU[rg], QU2); }
#pragma unroll
        for (int rg = 0; rg < 4; ++rg) { PU4 = MFMA4F(QU2[rg], PU2[rg], PU4); QU4 = MFMA4F(PU2[rg], QU2[rg], QU4); T1 = MFMA4F(QU2[rg] + EY[rg], PU[rg] + EY[rg], T1); }
#pragma unroll
        for (int rg = 0; rg < 4; ++rg) { QU8 = MFMA4F(PU4[rg], QU4[rg], QU8); T2 = MFMA4F(QU4[rg] + EY[rg], T1[rg], T2); }
#pragma unroll
        for (int rg = 0; rg < 4; ++rg) T3 = MFMA4F(QU8[rg] + EY[rg], T2[rg], T3);
        *(LAS f32x4v*)(DI + wave_s * 256 + lr * 16 + 4 * lq) = T3;
    }
    LDS_BARRIER();
    {
        f32x4v xr[2][4];
#pragma unroll
        for (int B = 0; B < 4; ++B) {
            f32x4v pa[2], pb[2], dv[2];
#pragma unroll
            for (int pp = 0; pp < 2; ++pp) {
                const int pr = 2 * wave_s + pp, d = pr >> 3, e = 16 * (pr & 7) + lr;
                const LAS bf16_t* src = e < 64 ? vv + e : kk + (e - 64);
                const LAS float* sc = gs + 384 + d * 128 + (e < 64 ? 0 : 64);
#pragma unroll
                for (int rg = 0; rg < 4; ++rg) { const int rho = 16 * B + 4 * lq + rg, i = d ? 63 - rho : rho; pa[pp][rg] = sc[i] * bf2f(src[i * 72]); pb[pp][rg] = 0.f; }
                dv[pp] = *(const LAS f32x4v*)(DI + (d * 4 + B) * 256 + lr * 16 + 4 * lq);
            }
#pragma unroll
            for (int Bp = 0; Bp < B; ++Bp) {
                float av[2][4];
#pragma unroll
                for (int pp = 0; pp < 2; ++pp) {
                    const LAS float* Mn = ((2 * wave_s + pp) >> 3) ? M1 : M0;
#pragma unroll
                    for (int rg = 0; rg < 4; ++rg) av[pp][rg] = Mn[(16 * Bp + 4 * lq + rg) * MS + 16 * B + lr];
                }
#pragma unroll
                for (int rg = 0; rg < 4; rg += 2)
#pragma unroll
                    for (int pp = 0; pp < 2; ++pp) {
                        pa[pp] = MFMA4F(av[pp][rg], xr[pp][Bp][rg], pa[pp]);
                        pb[pp] = MFMA4F(av[pp][rg + 1], xr[pp][Bp][rg + 1], pb[pp]);
                    }
            }
            f32x4v xa[2], xb[2];
#pragma unroll
            for (int pp = 0; pp < 2; ++pp) { pa[pp] = pa[pp] + pb[pp]; xa[pp] = (f32x4v){0.f, 0.f, 0.f, 0.f}; xb[pp] = xa[pp]; }
#pragma unroll
            for (int rg = 0; rg < 4; rg += 2)
#pragma unroll
                for (int pp = 0; pp < 2; ++pp) {
                    xa[pp] = MFMA4F(dv[pp][rg], pa[pp][rg], xa[pp]);
                    xb[pp] = MFMA4F(dv[pp][rg + 1], pa[pp][rg + 1], xb[pp]);
                }
#pragma unroll
            for (int pp = 0; pp < 2; ++pp) xr[pp][B] = xa[pp] + xb[pp];
        }
#pragma unroll
        for (int pp = 0; pp < 2; ++pp) {
            const int pr = 2 * wave_s + pp, d = pr >> 3, e = 16 * (pr & 7) + lr;
            LAS float* X = xs + d * (64 * XS) + e;
#pragma unroll
            for (int B = 0; B < 4; ++B)
#pragma unroll
                for (int rg = 0; rg < 4; ++rg) X[(16 * B + 4 * lq + rg) * XS] = xr[pp][B][rg];
        }
    }
#undef MFMA4F
    LDS_BARRIER();
    {
#pragma unroll
        for (int d = 0; d < 2; ++d) {
            const size_t recd = ((size_t)bh * 2 + d) * 68 + n;
            const LAS float* X = xs + d * (64 * XS);
            float o[8];
            {
                const u32x4 kw = *(const LAS u32x4*)(kT + r * 72 + 8 * (c ^ (r >> 3)));
                const float gl = gs[256 + d * 64 + (d ? 0 : 63)];
#pragma unroll
                for (int j = 0; j < 8; ++j) o[j] = ((j & 1) ? bfhi(kw[j >> 1]) : bflo(kw[j >> 1])) * __expf(gl - gs[256 + d * 64 + 8 * c + j]);
                *(u32x4*)(GKT_(p) + recd * 4096 + r * 64 + 8 * c) = pack8(o);
            }
#pragma unroll
            for (int j = 0; j < 8; ++j) { const int i = 8 * c + j, rho = d ? 63 - i : i; o[j] = X[rho * XS + r]; }
            *(u32x4*)(GUT_(p) + recd * 4096 + r * 64 + 8 * c) = pack8(o);
            { const int rho = d ? 63 - r : r;
#pragma unroll
              for (int j = 0; j < 8; ++j) o[j] = -X[rho * XS + 64 + 8 * c + j]; }
            *(u32x4*)(GWN_(p) + recd * 4096 + r * 64 + 8 * c) = pack8(o);
        }
        if (tid < 128) GGC_(p)[(size_t)task * 128 + tid] = gs[256 + tid] * 1.44269504088896f;
    }
    LDS_BARRIER();
}

struct GdnOps { bf16x8 aw[2], ak[2]; u32x2 uw[2]; float gl; };
DEV void gdn_ops_load(GdnOps& o, const bf16_t* gwn, const bf16_t* gkt, const bf16_t* gut, const float* ggc, int chain, int step, int it, int jt0, int lr, int lq) {
    const int dir = chain & 1, n = chain_chunk(dir, step);
    const size_t recd = (size_t)chain * 68 + n;
#pragma unroll
    for (int ks = 0; ks < 2; ++ks) {
        o.aw[ks] = *(const bf16x8*)(gwn + recd * 4096 + (16 * it + lr) * 64 + 32 * ks + 8 * lq);
        o.ak[ks] = *(const bf16x8*)(gkt + recd * 4096 + (16 * it + lr) * 64 + 32 * ks + 8 * lq);
    }
#pragma unroll
    for (int t = 0; t < 2; ++t) o.uw[t] = *(const u32x2*)(gut + recd * 4096 + (16 * (jt0 + t) + lr) * 64 + 16 * it + 4 * lq);
    o.gl = ggc[((size_t)(chain >> 1) * 68 + n) * 128 + dir * 64 + (dir == 0 ? 63 : 0)];
}
DEV void gdn_scan_chain(const DParams& p, int chain, LAS unsigned char* lds, int tid, int wave_s) {
    const int lane = tid & 63, lr = lane & 15, lq = lane >> 4, it = wave_s >> 1, jt0 = 2 * (wave_s & 1);
    const int dir = chain & 1;
    LAS bf16_t* ST = (LAS bf16_t*)lds;
    bf16_t* gwn = GWN_(p); const bf16_t* gkt = GKT_(p); bf16_t* gut = GUT_(p); const float* ggc = GGC_(p);
    f32x4v S[2];
#pragma unroll
    for (int t = 0; t < 2; ++t) S[t] = (f32x4v){0.f, 0.f, 0.f, 0.f};
    GdnOps o0, o1, o2, o3;
    gdn_ops_load(o0, gwn, gkt, gut, ggc, chain, 0, it, jt0, lr, lq); gdn_ops_load(o1, gwn, gkt, gut, ggc, chain, 1, it, jt0, lr, lq);
    gdn_ops_load(o2, gwn, gkt, gut, ggc, chain, 2, it, jt0, lr, lq); gdn_ops_load(o3, gwn, gkt, gut, ggc, chain, 3, it, jt0, lr, lq);
#define GDN_STEP(O, STEP) do { \
        const size_t recd = (size_t)chain * 68 + chain_chunk(dir, (STEP)); \
        LAS bf16_t* STb = ST + ((STEP) & 1) * (2 * 64 * 72); LAS bf16_t* VNb = STb + 64 * 72;     \
        f32x4v vn[2]; \
        _Pragma("unroll") for (int t = 0; t < 2; ++t) { \
            vn[t] = (f32x4v){bflo(O.uw[t].x), bfhi(O.uw[t].x), bflo(O.uw[t].y), bfhi(O.uw[t].y)}; \
            u32x2 sw; sw.x = pkbf(S[t][0], S[t][1]); sw.y = pkbf(S[t][2], S[t][3]); \
            *(LAS u32x2*)(STb + (16 * (jt0 + t) + lr) * 72 + 16 * it + 4 * lq) = sw; } \
        LDS_BARRIER(); \
        bf16x8 sf[2][2]; \
        _Pragma("unroll") for (int t = 0; t < 2; ++t) _Pragma("unroll") for (int ks = 0; ks < 2; ++ks) sf[t][ks] = *(const LAS bf16x8*)(STb + (16 * (jt0 + t) + lr) * 72 + 32 * ks + 8 * lq); \
        _Pragma("unroll") for (int ks = 0; ks < 2; ++ks) _Pragma("unroll") for (int t = 0; t < 2; ++t) vn[t] = MFMA16(O.aw[ks], sf[t][ks], vn[t]); \
        _Pragma("unroll") for (int t = 0; t < 2; ++t) { \
            u32x2 w; w.x = pkbf(vn[t][0], vn[t][1]); w.y = pkbf(vn[t][2], vn[t][3]); \
            *(LAS u32x2*)(VNb + (16 * (jt0 + t) + lr) * 72 + 16 * it + 4 * lq) = w; } \
        LDS_BARRIER(); \
        const float gt = ex2(O.gl); \
        bf16x8 vf[2][2]; \
        _Pragma("unroll") for (int t = 0; t < 2; ++t) _Pragma("unroll") for (int ks = 0; ks < 2; ++ks) vf[t][ks] = *(const LAS bf16x8*)(VNb + (16 * (jt0 + t) + lr) * 72 + 32 * ks + 8 * lq); \
          \
        { const u32x4 c0 = *(const LAS u32x4*)(STb + (tid >> 3) * 72 + 8 * (tid & 7)), c1 = *(const LAS u32x4*)(VNb + (tid >> 3) * 72 + 8 * (tid & 7)); \
            *(u32x4*)(gwn + recd * 4096 + tid * 8) = c0; *(u32x4*)(gut + recd * 4096 + tid * 8) = c1; } \
        _Pragma("unroll") for (int t = 0; t < 2; ++t) S[t] = S[t] * gt; \
        _Pragma("unroll") for (int ks = 0; ks < 2; ++ks) _Pragma("unroll") for (int t = 0; t < 2; ++t) S[t] = MFMA16(O.ak[ks], vf[t][ks], S[t]); \
        if ((STEP) + 4 < 68) gdn_ops_load(O, gwn, gkt, gut, ggc, chain, (STEP) + 4, it, jt0, lr, lq); \
    } while (0)
#pragma unroll
    for (int step = 0; step < 68; step += 4) { GDN_STEP(o0, step); GDN_STEP(o1, step + 1); GDN_STEP(o2, step + 2); GDN_STEP(o3, step + 3); }
#undef GDN_STEP
    __syncthreads();
}

template <bool GDN>
DEV void la_out_task(const DParams& p, int layer, int task, LAS unsigned char* lds, int gt, int gw) {
    const int n = task % 68, bh = task / 68, b = bh >> 2, h = bh & 3;
    const bool lat = n >= 4;
    const int row0 = chunk_row0(b, n);
    LAS bf16_t* q = (LAS bf16_t*)lds;
    LAS bf16_t* k = q + 64 * 72;
    LAS bf16_t* vT0 = k + 64 * 72;
    LAS bf16_t* vT1 = vT0 + 64 * 72;
    LAS bf16_t* ST0 = vT1 + 64 * 72;
    LAS bf16_t* ST1 = ST0 + 64 * 72;
    LAS bf16_t* A0 = ST1 + 64 * 72;
    LAS bf16_t* A1 = A0 + 64 * 72;
    LAS float* gcl = (LAS float*)(A1 + 64 * 72);
    const size_t s0 = ((size_t)bh * 2 + 0) * 68 + n, s1 = ((size_t)bh * 2 + 1) * 68 + n;
    const bf16_t* Pp = P_(p);
#pragma unroll
    for (int rep = 0; rep < 2; ++rep) {
        const int idx = gt + 256 * rep, r = idx >> 3, c = idx & 7;
        const bf16_t* prow = Pp + (size_t)(row0 + r) * PST;
        float o[8];
        if (GDN) {
            const float* cw = lp(p.gdn_conv_w) + (size_t)layer * 3 * 768;
            const int slen = n < 4 ? CTX : SQ, t0 = n < 4 ? n * 64 : (n - 4) * 64;
            const bool hasp = t0 + r > 0, hasn = t0 + r + 1 < slen;
            gdn_conv8(cw, prow + C_GQ + h * 64 + 8 * c, h * 64 + 8 * c, hasp, hasn, o);
            l2norm8(o, 0.125f);
            *(LAS u32x4*)(q + r * 72 + 8 * c) = pack8(o);
            gdn_conv8(cw, prow + C_GK + h * 64 + 8 * c, 256 + h * 64 + 8 * c, hasp, hasn, o);
            l2norm8(o, 1.0f);
            *(LAS u32x4*)(k + r * 72 + 8 * c) = pack8(o);
            *(LAS u32x4*)(vT0 + r * 72 + 8 * c) = *(const u32x4*)(GUT_(p) + s0 * 4096 + r * 64 + 8 * c);
            *(LAS u32x4*)(vT1 + r * 72 + 8 * c) = *(const u32x4*)(GUT_(p) + s1 * 4096 + r * 64 + 8 * c);
            *(LAS u32x4*)(ST0 + r * 72 + 8 * c) = *(const u32x4*)(GWN_(p) + s0 * 4096 + r * 64 + 8 * c);
            *(LAS u32x4*)(ST1 + r * 72 + 8 * c) = *(const u32x4*)(GWN_(p) + s1 * 4096 + r * 64 + 8 * c);
        } else {
            load_rope8(p, prow + C_RQ + h * 64, c, lat, (n - 4) * 64 + r, 1.0f, o);
            *(LAS u32x4*)(q + r * 72 + 8 * c) = pack8(o);
            load_rope8(p, prow + C_RK + h * 64, c, lat, (n - 4) * 64 + r, 0.125f, o);
            *(LAS u32x4*)(k + r * 72 + 8 * c) = pack8(o);
            const u32x4 vw = *(const u32x4*)(RVT_(p) + (size_t)task * 4096 + r * 64 + 8 * c);
            *(LAS u32x4*)(vT0 + r * 72 + 8 * c) = vw;
            *(LAS u32x4*)(vT1 + r * 72 + 8 * c) = vw;
            *(LAS u32x4*)(ST0 + r * 72 + 8 * c) = *(const u32x4*)(RST_(p) + s0 * 4096 + r * 64 + 8 * c);
            *(LAS u32x4*)(ST1 + r * 72 + 8 * c) = *(const u32x4*)(RST_(p) + s1 * 4096 + r * 64 + 8 * c);
        }
    }
    if (gt < 128) {
        if (GDN) gcl[gt] = GGC_(p)[(size_t)task * 128 + gt];
        else { const int d = gt >> 6, i = gt & 63; gcl[gt] = ret_lg2(p, layer, d, h) * (float)(d == 0 ? i + 1 : 64 - i); }
    }
    const int lane = gt & 63, lr = lane & 15, lq = lane >> 4;
    const int gcol = (GDN ? C_GZ : C_RG) + h * 64, mcol = (GDN ? 768 : 0) + h * 64;
    const int tokr = row0 + 16 * gw + lr;
    u32x2 gz[4];
#pragma unroll
    for (int t = 0; t < 4; ++t) gz[t] = *(const u32x2*)(Pp + (size_t)tokr * PST + gcol + 16 * t + 4 * lq);
    LDS_BARRIER();
    {
        bf16x8 bq[2];
#pragma unroll
        for (int ks = 0; ks < 2; ++ks) bq[ks] = *(const LAS bf16x8*)(q + (16 * gw + lr) * 72 + 32 * ks + 8 * lq);
        const int i = 16 * gw + lr;
        const float gi0 = gcl[i], gi1 = gcl[64 + i];
#pragma unroll
        for (int jt = 0; jt < 4; ++jt) {
            f32x4v acc = (f32x4v){0.f, 0.f, 0.f, 0.f};
#pragma unroll
            for (int ks = 0; ks < 2; ++ks) acc = MFMA16(*(const LAS bf16x8*)(k + (16 * jt + lr) * 72 + 32 * ks + 8 * lq), bq[ks], acc);
            float f[4], g[4];
#pragma unroll
            for (int rg = 0; rg < 4; ++rg) {
                const int j = 16 * jt + 4 * lq + rg;
                f[rg] = i >= j ? acc[rg] * ex2(gi0 - gcl[j]) : 0.f;
                g[rg] = i <= j ? acc[rg] * ex2(gi1 - gcl[64 + j]) : 0.f;
            }
            u32x2 w0, w1; w0.x = pkbf(f[0], f[1]); w0.y = pkbf(f[2], f[3]); w1.x = pkbf(g[0], g[1]); w1.y = pkbf(g[2], g[3]);
            *(LAS u32x2*)(A0 + i * 72 + 16 * jt + 4 * lq) = w0;
            *(LAS u32x2*)(A1 + i * 72 + 16 * jt + 4 * lq) = w1;
        }
    }
    asm volatile("s_waitcnt lgkmcnt(0)" ::: "memory");
    f32x4v o[4];
#pragma unroll
    for (int t = 0; t < 4; ++t) o[t] = (f32x4v){0.f, 0.f, 0.f, 0.f};
#pragma unroll
    for (int d = 0; d < 2; ++d) {
        const LAS bf16_t* ST = d == 0 ? ST0 : ST1;
        const LAS bf16_t* AT = d == 0 ? A0 : A1;
        const LAS bf16_t* VT = d == 0 ? vT0 : vT1;
        bf16x8 bq[2], ba[2];
#pragma unroll
        for (int ks = 0; ks < 2; ++ks) {
            bq[ks] = *(const LAS bf16x8*)(q + (16 * gw + lr) * 72 + 32 * ks + 8 * lq);
            ba[ks] = *(const LAS bf16x8*)(AT + (16 * gw + lr) * 72 + 32 * ks + 8 * lq);
        }
        const float rsc = ex2(gcl[d * 64 + 16 * gw + lr]);
#pragma unroll
        for (int t = 0; t < 4; ++t) {
            f32x4v acc = (f32x4v){0.f, 0.f, 0.f, 0.f};
#pragma unroll
            for (int ks = 0; ks < 2; ++ks) acc = MFMA16(*(const LAS bf16x8*)(ST + (16 * t + lr) * 72 + 32 * ks + 8 * lq), bq[ks], acc);
            acc = acc * rsc;
#pragma unroll
            for (int ks = 0; ks < 2; ++ks) acc = MFMA16(*(const LAS bf16x8*)(VT + (16 * t + lr) * 72 + 32 * ks + 8 * lq), ba[ks], acc);
            o[t] = o[t] + acc;
        }
    }
    {
        const float* nw = GDN ? lp(p.gdn_norm_w) + (size_t)layer * 64 : lp(p.ret_norm_w) + (size_t)layer * 256 + h * 64;
        float ss = 0.f;
#pragma unroll
        for (int t = 0; t < 4; ++t) ss += (o[t][0] * o[t][0] + o[t][1] * o[t][1]) + (o[t][2] * o[t][2] + o[t][3] * o[t][3]);
        ss += shfl_xor_l(ss, 16); ss += shfl_xor_l(ss, 32);
        const float rs = __builtin_amdgcn_rsqf(ss * (1.0f / 64.0f) + 1e-6f);
        bf16_t* mp = H_(p) + (size_t)tokr * 1024 + mcol + 4 * lq;
#pragma unroll
        for (int t = 0; t < 4; ++t) {
            const f32x4v w4 = *(const f32x4v*)(nw + 16 * t + 4 * lq);
            const float g0 = bflo(gz[t].x), g1 = bfhi(gz[t].x), g2 = bflo(gz[t].y), g3 = bfhi(gz[t].y);
            u32x2 w; w.x = pkbf(o[t][0] * rs * w4[0] * siluf(g0), o[t][1] * rs * w4[1] * siluf(g1)); w.y = pkbf(o[t][2] * rs * w4[2] * siluf(g2), o[t][3] * rs * w4[3] * siluf(g3));
            *(u32x2*)(mp + 16 * t) = w;
        }
    }
    LDS_BARRIER();
}


DEV void mix_prep_item(const DParams& p, int item2, LAS unsigned char* lds, int tid) {
    const int item = item2 >> 1, half = item2 & 1;
    const int b = item / 68, n = item % 68;
    const bool lat = n >= 4;
    const int row0 = chunk_row0(b, n), r = tid >> 3, c = tid & 7, t = (n - 4) * 64 + r;
    const bf16_t* prow = P_(p) + (size_t)(row0 + r) * PST;
    bf16_t* rktb = RKT_(p); bf16_t* rvtb = RVT_(p); bf16_t* ktb = KT_(p); bf16_t* vtb = VT_(p);
    u32x4 kx[3], kp[3], vx[3];
#pragma unroll
    for (int q = 0; q < 3; ++q) {
        const int kc = q < 2 ? C_RK + (2 * half + q) * 64 : C_SK + half * 64, vc = q < 2 ? C_RV + (2 * half + q) * 64 : C_SV + half * 64;
        kx[q] = *(const u32x4*)(prow + kc + 8 * c);
        kp[q] = lat ? *(const u32x4*)(prow + kc + 8 * (c ^ 2)) : kx[q];
        vx[q] = *(const u32x4*)(prow + vc + 8 * c);
    }
    f32x4 rt[4];
    {
        const int pos = lat ? ((c >> 2) == 0 ? t / 64 : t % 64) : 0;
        const float* rp = ROPE_(p) + (pos * 16 + 8 * (c & 1)) * 2;
#pragma unroll
        for (int q4 = 0; q4 < 4; ++q4) rt[q4] = *(const f32x4*)(rp + 4 * q4);
    }
    LAS bf16_t* tiles = (LAS bf16_t*)lds;
    const bool first = (c & 2) == 0;
    const int posk = kswz(r);
#pragma unroll
    for (int q = 0; q < 3; ++q) {
        float o[8];
#pragma unroll
        for (int j = 0; j < 8; ++j) {
            const float mine = (j & 1) ? bfhi(kx[q][j >> 1]) : bflo(kx[q][j >> 1]);
            if (lat) {
                const float oth = (j & 1) ? bfhi(kp[q][j >> 1]) : bflo(kp[q][j >> 1]);
                const float cs = rt[j >> 1][2 * (j & 1)], sn = rt[j >> 1][2 * (j & 1) + 1];
                o[j] = first ? mine * cs - oth * sn : oth * sn + mine * cs;
            } else o[j] = mine;
        }
        if (q < 2) {
            LAS bf16_t* kt = tiles + q * (64 * 72);
            LAS bf16_t* vt = tiles + (2 + q) * (64 * 72);
#pragma unroll
            for (int j = 0; j < 8; ++j) {
                kt[(8 * c + j) * 72 + (r ^ (8 * c))] = f2bf(o[j] * 0.125f);
                vt[(8 * c + j) * 72 + (r ^ (8 * c))] = (bf16_t)((vx[q][j >> 1] >> (16 * (j & 1))) & 0xffffu);
            }
        } else {
            const size_t rec = (size_t)(b * 2 + half) * 68 + n;
            *(u32x4*)(ktb + rec * 4096 + r * 64 + ((c ^ ((r >> 1) & 7)) * 8)) = pack8(o);
            LAS bf16_t* vt = tiles + 4 * (64 * 72);
#pragma unroll
            for (int j = 0; j < 8; ++j) vt[(8 * c + j) * 72 + (posk ^ (8 * c))] = (bf16_t)((vx[q][j >> 1] >> (16 * (j & 1))) & 0xffffu);
        }
    }
    LDS_BARRIER();
#pragma unroll
    for (int q = 0; q < 2; ++q) {
        const size_t rec = (size_t)(b * 4 + 2 * half + q) * 68 + n;
        *(u32x4*)(rktb + rec * 4096 + r * 64 + 8 * c) = *(const LAS u32x4*)(tiles + q * (64 * 72) + r * 72 + 8 * (c ^ (r >> 3)));
        *(u32x4*)(rvtb + rec * 4096 + r * 64 + 8 * c) = *(const LAS u32x4*)(tiles + (2 + q) * (64 * 72) + r * 72 + 8 * (c ^ (r >> 3)));
    }
    {
        const size_t rec = (size_t)(b * 2 + half) * 68 + n;
        *(u32x4*)(vtb + rec * 4096 + r * 64 + ((c ^ ((r >> 1) & 7)) * 8)) = *(const LAS u32x4*)(tiles + 4 * (64 * 72) + r * 72 + 8 * (c ^ (r >> 3)));
    }
    LDS_BARRIER();
}


DEV void ctx_res_tile(const DParams& p, int tile, const bf16_t* A, int lda, const bf16_t* Wt, int K, const float* xsrc, const float* modl, int gidx, const float* nwsc, bf16_t* An,
                      LAS unsigned char* lds, int tid, int wave_s) {
    const int rb = tile >> 3, cb = tile & 7, lane = tid & 63, lr = lane & 15, lq = lane >> 4, rt = wave_s & 3, ch = wave_s >> 2;
    const int nk = K / 64;
    const int ar = tid >> 3, ac = tid & 7;
    const bf16_t* ag = A + (size_t)(64 * rb + ar) * lda + 8 * ac;
    const bf16_t* bg0 = Wt + (size_t)(128 * cb + ar) * K + 8 * ac;
    const bf16_t* bg1 = bg0 + (size_t)64 * K;
    LAS bf16_t* buf = (LAS bf16_t*)lds;
    f32x4v acc[4];
#pragma unroll
    for (int j = 0; j < 4; ++j) acc[j] = (f32x4v){0.f, 0.f, 0.f, 0.f};
    u32x4 ra0, rb00, rb10, ra1 = (u32x4){0u, 0u, 0u, 0u}, rb01 = ra1, rb11 = ra1;
#define CT_LOAD(S, KT) do { ra##S = *(const u32x4*)(ag + 64 * (KT)); rb0##S = *(const u32x4*)(bg0 + 64 * (KT)); rb1##S = *(const u32x4*)(bg1 + 64 * (KT)); } while (0)
#define CT_STORE(S, BP) do { *(LAS u32x4*)((BP) + ar * 72 + 8 * ac) = ra##S; *(LAS u32x4*)((BP) + 64 * 72 + ar * 72 + 8 * ac) = rb0##S; *(LAS u32x4*)((BP) + 64 * 72 + (ar + 64) * 72 + 8 * ac) = rb1##S; } while (0)
#define CT_COMPUTE(CUR) do { bf16x8 af[2], bfr[4][2]; \
        _Pragma("unroll") for (int ks = 0; ks < 2; ++ks) { af[ks] = *(const LAS bf16x8*)((CUR) + (16 * rt + lr) * 72 + 32 * ks + 8 * lq); \
            _Pragma("unroll") for (int j = 0; j < 4; ++j) bfr[j][ks] = *(const LAS bf16x8*)((CUR) + 64 * 72 + (64 * ch + 16 * j + lr) * 72 + 32 * ks + 8 * lq); } \
        _Pragma("unroll") for (int ks = 0; ks < 2; ++ks) _Pragma("unroll") for (int j = 0; j < 4; ++j) acc[j] = MFMA16(af[ks], bfr[j][ks], acc[j]); } while (0)
    LAS bf16_t* buf0 = buf; LAS bf16_t* buf1 = buf + 192 * 72;
    CT_LOAD(0, 0);
    CT_STORE(0, buf0);
    if (nk > 1) CT_LOAD(1, 1);
    if (nk > 2) CT_LOAD(0, 2);
    LDS_BARRIER();
    for (int kt = 0; kt < nk; kt += 2) {
        if (kt + 1 < nk) CT_STORE(1, buf1);
        if (kt + 3 < nk) CT_LOAD(1, kt + 3);
        CT_COMPUTE(buf0);
        LDS_BARRIER();
        if (kt + 1 < nk) {
            if (kt + 2 < nk) CT_STORE(0, buf0);
            if (kt + 4 < nk) CT_LOAD(0, kt + 4);
            CT_COMPUTE(buf1);
            LDS_BARRIER();
        }
    }
#undef CT_LOAD
#undef CT_STORE
#undef CT_COMPUTE
    const int c0 = 128 * cb + 64 * ch + lr;
    float gv[4], nv[4];
#pragma unroll
    for (int j = 0; j < 4; ++j) { gv[j] = modl[(size_t)NB * NMOD * DM + gidx * DM + c0 + 16 * j]; nv[j] = nwsc[(size_t)NB * DM + c0 + 16 * j]; }
#pragma unroll
    for (int rg = 0; rg < 4; ++rg) {
        const int R = 64 * rb + 16 * rt + 4 * lq + rg;
        float xo[4];
#pragma unroll
        for (int j = 0; j < 4; ++j) xo[j] = xsrc[(size_t)R * DM + c0 + 16 * j];
        float sq = 0.f;
#pragma unroll
        for (int j = 0; j < 4; ++j) {
            const float xn = xo[j] + gv[j] * acc[j][rg];
            XC_(p)[(size_t)R * DM + c0 + 16 * j] = xn;
            An[(size_t)R * DM + c0 + 16 * j] = f2bf(xn * nv[j]);
            sq += xn * xn;
        }
        sq = row16_sum(sq);
        if (lr == 0) SSQ_(p)[(size_t)R * 16 + cb * 2 + ch] = sq;
    }
    LDS_BARRIER();
}

DEV void gate_cols(const DParams& p, int layer, LAS unsigned char* lds, int tid, int wave_s) {
    const int lane = tid & 63, lr = lane & 15, lq = lane >> 4;
    LAS float* part = (LAS float*)lds;
    const bf16_t* Wt = WIN_(p) + (size_t)layer * NPAD * DM + (size_t)(C_GA + lr) * DM + 128 * wave_s + 8 * lq;
    for (int rgp = blockIdx.x; rgp < 256; rgp += gridDim.x) {
        const int R0 = rgp * (ROWS / 256);
        bf16x8 bfr[4], afr[9][4];
#pragma unroll
        for (int ks = 0; ks < 4; ++ks) bfr[ks] = *(const bf16x8*)(Wt + 32 * ks);
#pragma unroll
        for (int t = 0; t < 9; ++t) {
            const int rl = 16 * t + lr, rc = rl < ROWS / 256 ? rl : ROWS / 256 - 1;
            const bf16_t* ap = H_(p) + (size_t)(R0 + rc) * DM + 128 * wave_s + 8 * lq;
#pragma unroll
            for (int ks = 0; ks < 4; ++ks) afr[t][ks] = *(const bf16x8*)(ap + 32 * ks);
        }
        const int orow = tid >> 1, oc = 8 * (tid & 1), R = R0 + (orow < ROWS / 256 ? orow : 0);
        const f32x4* sp = (const f32x4*)(SSQ_(p) + (size_t)R * 16);
        const f32x4 s0 = sp[0], s1 = sp[1], s2 = sp[2], s3 = sp[3];
        const float* bp = BIAS_(p) + ((size_t)(layer * 2 + 0) * 9 + modrow(R)) * 5632 + C_GA + oc;
        const f32x4 b0 = *(const f32x4*)bp, b1 = *(const f32x4*)(bp + 4);
#pragma unroll
        for (int t = 0; t < 9; ++t) {
            f32x4v acc = (f32x4v){0.f, 0.f, 0.f, 0.f};
#pragma unroll
            for (int ks = 0; ks < 4; ++ks) acc = MFMA16(afr[t][ks], bfr[ks], acc);
#pragma unroll
            for (int rg = 0; rg < 4; ++rg) part[(wave_s * 9 + t) * 256 + (4 * lq + rg) * 16 + lr] = acc[rg];
        }
        LDS_BARRIER();
        if (orow < ROWS / 256) {
            f32x4 a0 = (f32x4){0.f, 0.f, 0.f, 0.f}, a1 = a0;
#pragma unroll
            for (int w8 = 0; w8 < 8; ++w8) {
                const LAS f32x4* pp = (const LAS f32x4*)(part + (w8 * 9 + (orow >> 4)) * 256 + (orow & 15) * 16 + oc);
                a0 = a0 + pp[0]; a1 = a1 + pp[1];
            }
            const float ss = ((s0.x + s0.y) + (s0.z + s0.w)) + ((s1.x + s1.y) + (s1.z + s1.w)) + ((s2.x + s2.y) + (s2.z + s2.w)) + ((s3.x + s3.y) + (s3.z + s3.w));
            const float rs = __builtin_amdgcn_rsqf(ss * (1.0f / DM) + 1e-6f);
            a0 = a0 * rs + b0; a1 = a1 * rs + b1;
            u32x4 w; w.x = pg8::cvt_pk_bf16(a0.x, a0.y); w.y = pg8::cvt_pk_bf16(a0.z, a0.w); w.z = pg8::cvt_pk_bf16(a1.x, a1.y); w.w = pg8::cvt_pk_bf16(a1.z, a1.w);
            *(u32x4*)(P_(p) + (size_t)R * PST + C_GA + oc) = w;
        }
        LDS_BARRIER();
    }
}

DEV void ph_m1(const DParams& p, int layer, LAS unsigned char* lds, int wave_s) {
    wave_s = launder_s(wave_s);
    const int tid = get_tid(wave_s);
    {
        GdnPre pre;
        int t = blockIdx.x;
        if (t < NB * 4 * 68) gdn_pre_load(pre, p, t, tid);
        for (; t < NB * 4 * 68; t += gridDim.x) {
            const int nt = t + (int)gridDim.x;
            gdn_prep_task(p, layer, t, nt < NB * 4 * 68 ? nt : -1, pre, lds, tid, wave_s);
        }
    }
    for (int t = (int)gridDim.x - 1 - (int)blockIdx.x; t < 2 * NB * 68; t += gridDim.x) mix_prep_item(p, t, lds, tid);
}
DEV void ph_m2(const DParams& p, int layer, bool need_ctx, LAS unsigned char* lds, int wave_s) {
    wave_s = launder_s(wave_s);
    const int tid = get_tid(wave_s);
    const int rb = (int)gridDim.x - 1 - (int)blockIdx.x;
    for (int ch = rb; ch < NB * 4 * 2; ch += gridDim.x) gdn_scan_chain(p, ch, lds, tid, wave_s);
    for (int ch = rb - NB * 4 * 2; ch < NB * 4 * 2; ch += gridDim.x) if (ch >= 0) ret_scan_chain(p, layer, ch, tid, wave_s);
    const int nunits = NB * 2 * 64 + (need_ctx ? NB * 2 * 4 : 0);
    unsigned* ctr = (unsigned*)(lp(p.ws) + O_CTR) + layer * 16;
    volatile LAS unsigned* slot = (volatile LAS unsigned*)(lds + LDS_BYTES - 32);
    for (;;) {
        if (tid == 0) slot[0] = atomicAdd(ctr, 1u);
        LDS_BARRIER();
        const int u = (int)slot[0];
        LDS_BARRIER();
        if (u >= nunits) break;
        swa_unit(p, layer, u, lds, tid, wave_s);
    }
}
DEV void ph_m3(const DParams& p, int layer, bool need_ctx, LAS unsigned char* lds, int wave_s) {
    wave_s = launder_s(wave_s);
    const int tid = get_tid(wave_s), gt = tid & 255, gw = wave_s & 3;
    const int nch = need_ctx ? 68 : 64, ntask = NB * 4 * nch;
    for (int t = blockIdx.x; t < ntask; t += gridDim.x) {
        const int tk = (t / nch) * 68 + (68 - nch) + (t % nch);
        const int gwl = launder_s(gw);
        if (wave_s < 4) la_out_task<false>(p, layer, tk, lds, gt, gwl);
        else la_out_task<true>(p, layer, tk, lds + 74240, gt, gwl);
    }
}
DEV void ph_final(const DParams& p, int wave_s) {
    wave_s = launder_s(wave_s);
    const int tid_ = get_tid(wave_s), lane = tid_ & 63, gw = blockIdx.x * NW + (tid_ >> 6), ngw = gridDim.x * NW;
    for (int r = gw; r < NB * SQ; r += ngw) {
        f32x4* xr = (f32x4*)(lp(p.XL) + (size_t)r * DM) + lane;
        f32x4 v[4]; float s = 0.f;
#pragma unroll
        for (int j = 0; j < 4; ++j) { v[j] = xr[64 * j]; s += (v[j].x * v[j].x + v[j].y * v[j].y) + (v[j].z * v[j].z + v[j].w * v[j].w); }
        const float rs = 1.0f / sqrtf(wave_sum(s) * (1.0f / DM) + 1e-6f);
        const f32x4* w4 = (const f32x4*)lp(p.final_norm_w) + lane;
#pragma unroll
        for (int j = 0; j < 4; ++j) xr[64 * j] = v[j] * rs * w4[64 * j];
    }
}

__global__ void __launch_bounds__(NT, 2) mega(Params kargs) {
    extern __shared__ __attribute__((aligned(16))) unsigned char lds_raw[];
    LAS unsigned char* lds = (LAS unsigned char*)lds_raw;
    const int wave_s = __builtin_amdgcn_readfirstlane(threadIdx.x >> 6);
    volatile LAS unsigned* bst = (volatile LAS unsigned*)(lds + LDS_BYTES - 16);
    if (threadIdx.x == 0) { bst[0] = 0u; bst[1] = 0u; }
    __syncthreads();
    const XcdBarrier bar = xcd_barrier_post((unsigned*)(kargs.ws + O_BAR), bst, (int)threadIdx.x);
    cg::this_grid().sync();
#define GSYNC() xcd_barrier(bar, get_tid(wave_s))
    const int G = gridDim.x, bid = blockIdx.x;
    { const DParams p = load_params(); ph_prologue(p, lds, wave_s); }
    GSYNC();
    { const DParams p = load_params(); ph_pre0(p, lds, wave_s); }
    GSYNC();
    for (int layer = 0; layer < 2; ++layer) {
        const bool need_ctx = layer == 0;
        const int rlo = need_ctx ? 0 : NCR, M2 = ROWS - rlo;
        {
            const DParams p = load_params();
            pg8::Gemm g{H_(p), WIN_(p) + (size_t)layer * NPAD * DM, ROWS, C_GA, DM}; pg8::StaticOrder S; S.init(ROWS, C_GA, G, bid);
            EpiP E{P_(p), PST, SSQ_(p), BIAS_(p) + (size_t)(layer * 2 + 0) * 9 * 5632};
            pg8::gemm_phase<EpiP, pg8::StaticOrder, false>(lds, g, S, E, nullptr, wave_s);
            { const int wl = launder_s(wave_s); gate_cols(p, layer, lds, get_tid(wl), wl); }
        }
        GSYNC();
        { const DParams p = load_params(); ph_m1(p, layer, lds, wave_s); }
        GSYNC();
        { const DParams p = load_params(); ph_m2(p, layer, need_ctx, lds, wave_s); }
        GSYNC();
        { const DParams p = load_params(); ph_m3(p, layer, need_ctx, lds, wave_s); }
        GSYNC();
        {
            const DParams p = load_params(); const float* modl = MOD_(p) + (size_t)layer * (NB + 1) * NMOD * DM;
            pg8::Gemm g{H_(p) + (size_t)NCR * 1024, WOUT_(p) + (size_t)layer * DM * 1024, ROWS - NCR, DM, 1024}; pg8::StaticOrder S; S.init(ROWS - NCR, DM, G, bid);
            EpiRes E{layer == 0 ? lp(p.x) : (const float*)lp(p.XL), XC_(p), lp(p.XL), XC_(p), modl, 2, NCR,
                     NWSC_(p) + (size_t)(layer * 2 + 1) * 9 * DM, A2_(p), SSQ_(p)};
            pg8::gemm_phase<EpiRes, pg8::StaticOrder, false>(lds, g, S, E, nullptr, wave_s);
            if (layer == 0) { const int wl = launder_s(wave_s), tid = get_tid(wl);
                for (int t = bid; t < 256; t += G) ctx_res_tile(p, t, H_(p), 1024, WOUT_(p), 1024, lp(p.ctx), modl, 2, NWSC_(p) + (size_t)(0 * 2 + 1) * 9 * DM, A2_(p), lds, tid, wl); }
        }
        GSYNC();
        {
            const DParams p = load_params();
            pg8::Gemm g{A2_(p) + (size_t)rlo * 1024, WF1_(p) + (size_t)layer * 2 * DFF * DM, M2, 2 * DFF, DM}; pg8::StaticOrder S; S.init(M2, 2 * DFF, G, bid);
            EpiSwiglu E{P_(p) + (size_t)rlo * DFF, DFF, SSQ_(p), BIAS_(p) + (size_t)(layer * 2 + 1) * 9 * 5632, rlo};
            pg8::gemm_phase<EpiSwiglu, pg8::StaticOrder, false>(lds, g, S, E, nullptr, wave_s);
        }
        GSYNC();
        {
            const DParams p = load_params(); const float* modl = MOD_(p) + (size_t)layer * (NB + 1) * NMOD * DM;
            pg8::Gemm g{P_(p) + (size_t)NCR * DFF, WF2_(p) + (size_t)layer * DM * DFF, ROWS - NCR, DM, DFF}; pg8::StaticOrder S; S.init(ROWS - NCR, DM, G, bid);
            EpiRes E{lp(p.XL), XC_(p), lp(p.XL), XC_(p), modl, 5, NCR, layer == 0 ? NWSC_(p) + (size_t)(1 * 2 + 0) * 9 * DM : (const float*)nullptr, H_(p), SSQ_(p)};
            pg8::gemm_phase<EpiRes, pg8::StaticOrder, false>(lds, g, S, E, nullptr, wave_s);
            if (layer == 0) { const int wl = launder_s(wave_s), tid = get_tid(wl);
                for (int t = bid; t < 256; t += G) ctx_res_tile(p, t, P_(p), DFF, WF2_(p), DFF, XC_(p), modl, 5, NWSC_(p) + (size_t)(1 * 2 + 0) * 9 * DM, H_(p), lds, tid, wl); }
        }
        GSYNC();
    }
    { const DParams p = load_params(); ph_final(p, wave_s); }
}

extern "C" void kernel_launch(void* const* d_in, const int* in_sizes, int n_in, void* d_out, int out_size, void* d_ws, size_t ws_size,
                              hipStream_t stream) {
    static int grid_blocks = 0;
    if (!grid_blocks) {
        int dev = 0, cus = 0, per_cu = 0;
        (void)hipGetDevice(&dev);
        (void)hipDeviceGetAttribute(&cus, hipDeviceAttributeMultiprocessorCount, dev);
        (void)hipFuncSetAttribute((const void*)mega, hipFuncAttributeMaxDynamicSharedMemorySize, LDS_BYTES);
        (void)hipOccupancyMaxActiveBlocksPerMultiprocessor(&per_cu, (const void*)mega, NT, LDS_BYTES);
        if (per_cu < 1) { fprintf(stderr, "occupancy query says %d blocks/CU\n", per_cu); per_cu = 1; }
        grid_blocks = cus;
    }
    Params p{};
    const float** ip = (const float**)&p;
    for (int i = 0; i < 20; ++i) ip[i] = (const float*)d_in[i];
    p.XL = (float*)d_out;
    p.ws = (char*)d_ws;
    if (WS_END > ws_size) { fprintf(stderr, "ws too small: need %zu have %zu\n", (size_t)WS_END, ws_size); return; }
    (void)hipMemsetAsync((char*)d_ws + O_BAR, 0, BAR_BYTES, stream);
    void* args[] = {&p};
    hipError_t e = hipLaunchCooperativeKernel((void*)mega, dim3(grid_blocks), dim3(NT), args, LDS_BYTES, stream);
    if (e != hipSuccess) fprintf(stderr, "cooperative launch failed: %s (grid %d)\n", hipGetErrorString(e), grid_blocks);
}
```

```cpp
#include <hip/hip_runtime.h>
#include <hip/hip_cooperative_groups.h>
#include <cstdio>
#include <cstdint>
namespace cg = cooperative_groups;
__device__ __forceinline__ int lane_id();
__device__ __forceinline__ int launder_s(int v);
namespace pg8 {
#define PG8_LAS __attribute__((address_space(3)))
typedef unsigned short bf16_t;
typedef short bf16x8 __attribute__((ext_vector_type(8)));
typedef float f32x4 __attribute__((ext_vector_type(4)));
typedef unsigned u32x4 __attribute__((ext_vector_type(4)));
constexpr int BM = 256, BK = 64, HALF = 128, HTB = HALF * BK * 2  , STAGE_BYTES = 8 * HTB, NXCD = 8, WGM = 8;

__host__ __device__ __forceinline__ int lds_byte(int r, int c) { const int st = (r >> 4) * 2 + (c >> 5), rr = r & 15, cc = c & 31, ob = rr * 64 + cc * 2; return st * 1024 + (ob ^ (((ob >> 9) & 1) << 5)); }
__host__ __device__ __forceinline__ void stage_rc(int b, int& R, int& C) { const int st = b / 1024, sb = b % 1024, swz = sb ^ (((sb >> 9) & 1) << 5); R = (st >> 1) * 16 + swz / 64; C = (st & 1) * 32 + (swz % 64) / 2; }
__host__ __device__ __forceinline__ int perm32(int rho) { const int n = rho >> 4, i = rho & 15; return 8 * (i >> 2) + 4 * n + (i & 3); }
struct Unit { int pm, pn; };
struct Gemm { const bf16_t* A; const bf16_t* Bt; int M, N, K; };
struct StaticOrder {
    int nM, nN, nwg, G, c;
    __host__ __device__ void init(int M, int N, int G_, int c_) { nM = M / BM; nN = N / BM; nwg = nM * nN; G = G_; c = c_; }
    __host__ __device__ bool next(int i, Unit& u) const {
        const long L = (long)i * G + c; if (L >= nwg) return false;
        int wgid = (int)L; { const int q = nwg / NXCD, r = nwg % NXCD, xcd = wgid % NXCD, off = wgid / NXCD; wgid = (xcd < r ? xcd * (q + 1) : r * (q + 1) + (xcd - r) * q) + off; }
        const int nig = WGM * nN, gid = wgid / nig, fm = gid * WGM, gsz = (nM - fm) < WGM ? (nM - fm) : WGM;
        u.pm = fm + ((wgid % nig) % gsz); u.pn = (wgid % nig) / gsz; return true;
    }
    __device__ __forceinline__ void a_ready(const Unit&) const {}
    __device__ __forceinline__ void done(const Unit&) const {}
};
__device__ __forceinline__ unsigned cvt_pk_bf16(float lo, float hi) { unsigned r; asm volatile("v_cvt_pk_bf16_f32 %0, %1, %2" : "=v"(r) : "v"(lo), "v"(hi)); return r; }
template <class Epi, class Sched, bool STAMP = false>
__device__ __forceinline__ void gemm_phase(PG8_LAS unsigned char* lds, const Gemm g, const Sched& S, const Epi& E, unsigned long long* stamps, int wave_s) {
    const int wid = launder_s(wave_s), tid = wid * 64 + lane_id(), lane = tid & 63, wr = wid >> 2, wc = wid & 3, fr = lane & 15, fq = lane >> 4;
    const int K = g.K, nt = K / BK;
    int ts_lo = 0, ts_hi = 0, nts = 0; const unsigned long long rt_entry = STAMP ? (unsigned long long)wall_clock64() : 0ull;
#define PG8_STAMP() do { if (STAMP && wid == 0 && nts < 64) { const unsigned long long _c = (unsigned long long)clock64(); \
        ts_lo = (lane == nts) ? (int)(unsigned)_c : ts_lo; ts_hi = (lane == nts) ? (int)(unsigned)(_c >> 32) : ts_hi; ++nts; } } while (0)
    PG8_STAMP();
    unsigned voffA[2], voffB[2];
#pragma unroll
    for (int i = 0; i < 2; ++i) { int R, C; stage_rc(tid * 16 + i * 8192, R, C); const int Rb = Epi::PERM ? ((R & ~31) + perm32(R & 31)) : R;
        voffA[i] = (unsigned)(R * K + C) * 2u; voffB[i] = (unsigned)(Rb * K + C) * 2u; }
    const size_t kstep = (size_t)(BK * 2);
    const size_t hstep = (size_t)HALF * K * 2;
    const size_t tstep = 2 * hstep;
    const unsigned ldsw = (unsigned)wid * 1024u;
    const int aoff = lds_byte(wr * 64 + fr, fq * 8), boff = lds_byte(wc * 32 + fr, fq * 8);
#define PG8_SA(b, h) (((b) * 2 + (h)) * HTB)
#define PG8_SB(b, h) ((4 + (b) * 2 + (h)) * HTB)
#define PG8_STAGE(bufoff, gbase, voff) do { _Pragma("unroll") for (int _i = 0; _i < 2; ++_i) \
        __builtin_amdgcn_global_load_lds((const unsigned*)((const char*)(gbase) + (voff)[_i]), (PG8_LAS unsigned*)(lds + (bufoff) + ldsw + _i * 8192), 16, 0, 0); } while (0)
#define PG8_LDA(dst, b, h) do { _Pragma("unroll") for (int m = 0; m < 4; ++m) _Pragma("unroll") for (int k = 0; k < 2; ++k) dst[m][k] = *(const PG8_LAS bf16x8*)(lds + PG8_SA(b, h) + aoff + m * 2048 + k * 1024); } while (0)
#define PG8_LDB(dst, b, h) do { _Pragma("unroll") for (int n = 0; n < 2; ++n) _Pragma("unroll") for (int k = 0; k < 2; ++k) dst[n][k] = *(const PG8_LAS bf16x8*)(lds + PG8_SB(b, h) + boff + n * 2048 + k * 1024); } while (0)
#define PG8_MMA(ai, bj, At, Bt) do { __builtin_amdgcn_s_setprio(1); _Pragma("unroll") for (int m = 0; m < 4; ++m) _Pragma("unroll") for (int n = 0; n < 2; ++n) _Pragma("unroll") for (int k = 0; k < 2; ++k) \
        acc[ai][bj][m][n] = __builtin_amdgcn_mfma_f32_16x16x32_bf16(Bt[n][k], At[m][k], acc[ai][bj][m][n], 0, 0, 0); __builtin_amdgcn_s_setprio(0); } while (0)
#define PG8_WAIT_V(n) asm volatile("s_waitcnt vmcnt(" #n ")" ::: "memory")
#define PG8_WAIT_L(n) asm volatile("s_waitcnt lgkmcnt(" #n ")" ::: "memory")
#define PG8_BAR __builtin_amdgcn_s_barrier()
#define PG8_SCHED __builtin_amdgcn_sched_barrier(0)
    Unit cur, nxt; int ui = 0;
    if (!S.next(0, cur)) return;
    f32x4 acc[2][2][4][2];
#pragma unroll
    for (int a = 0; a < 2; ++a)
#pragma unroll
        for (int b = 0; b < 2; ++b)
#pragma unroll
            for (int m = 0; m < 4; ++m)
#pragma unroll
                for (int n = 0; n < 2; ++n) acc[a][b][m][n] = (f32x4){0.f, 0.f, 0.f, 0.f};
    bf16x8 At[4][2], B0[2][2], B1[2][2];
    const char* cA = (const char*)g.A + (size_t)cur.pm * tstep; const char* cB = (const char*)g.Bt + (size_t)cur.pn * tstep;
    S.a_ready(cur);
    PG8_STAGE(PG8_SB(0, 0), cB, voffB); PG8_STAGE(PG8_SA(0, 0), cA, voffA); PG8_STAGE(PG8_SB(0, 1), cB + hstep, voffB); PG8_STAGE(PG8_SA(0, 1), cA + hstep, voffA);
    if (wr == 1) PG8_BAR;
    PG8_WAIT_V(4); PG8_BAR;
    PG8_STAGE(PG8_SB(1, 0), cB + kstep, voffB); PG8_STAGE(PG8_SA(1, 0), cA + kstep, voffA); PG8_STAGE(PG8_SB(1, 1), cB + hstep + kstep, voffB);
    PG8_WAIT_V(6); PG8_BAR;
    PG8_STAMP();
    for (;;) {
        const bool has_next = S.next(ui + 1, nxt);
        const char* nA = has_next ? (const char*)g.A + (size_t)nxt.pm * tstep : cA; const char* nB = has_next ? (const char*)g.Bt + (size_t)nxt.pn * tstep : cB;
        for (int t = 0; t < nt; t += 2) {
            const bool last = (t == nt - 2);
            const char* a1 = cA + (size_t)(t + 1) * kstep;
            const char* a2 = last ? nA : cA + (size_t)(t + 2) * kstep; const char* b2 = last ? nB : cB + (size_t)(t + 2) * kstep;
            const char* a3 = a2 + kstep; const char* b3 = b2 + kstep;
            if (last && has_next) S.a_ready(nxt);
            PG8_LDB(B0, 0, 0); PG8_SCHED; PG8_LDA(At, 0, 0); PG8_STAGE(PG8_SA(1, 1), a1 + hstep, voffA);
            PG8_WAIT_L(8); PG8_BAR; PG8_WAIT_L(0); PG8_MMA(0, 0, At, B0); PG8_BAR; PG8_SCHED;
            PG8_LDB(B1, 0, 1); PG8_STAGE(PG8_SB(0, 0), b2, voffB);
            PG8_BAR; PG8_WAIT_L(0); PG8_MMA(0, 1, At, B1); PG8_BAR;
            PG8_LDA(At, 0, 1); PG8_STAGE(PG8_SA(0, 0), a2, voffA);
            PG8_BAR; PG8_WAIT_L(0); PG8_MMA(1, 0, At, B0); PG8_BAR; PG8_SCHED;
            PG8_STAGE(PG8_SB(0, 1), b2 + hstep, voffB);
            PG8_WAIT_V(6); PG8_BAR; PG8_MMA(1, 1, At, B1); PG8_BAR;
            PG8_LDB(B0, 1, 0); PG8_SCHED; PG8_LDA(At, 1, 0); PG8_STAGE(PG8_SA(0, 1), a2 + hstep, voffA);
            PG8_WAIT_L(8); PG8_BAR; PG8_WAIT_L(0); PG8_MMA(0, 0, At, B0); PG8_BAR; PG8_SCHED;
            PG8_LDB(B1, 1, 1); PG8_STAGE(PG8_SB(1, 0), b3, voffB);
            PG8_BAR; PG8_WAIT_L(0); PG8_MMA(0, 1, At, B1); PG8_BAR;
            PG8_LDA(At, 1, 1); PG8_STAGE(PG8_SA(1, 0), a3, voffA);
            PG8_BAR; PG8_WAIT_L(0); PG8_MMA(1, 0, At, B0); PG8_BAR; PG8_SCHED;
            PG8_STAGE(PG8_SB(1, 1), b3 + hstep, voffB);
            PG8_WAIT_V(6); PG8_BAR; PG8_MMA(1, 1, At, B1); PG8_BAR;
        }
        PG8_STAMP();
        if constexpr (!Epi::AFTER_DRAIN) { E(acc, cur, wr, wc, fr, fq); S.done(cur); }
        PG8_STAMP();
        if (!has_next) break;
#pragma unroll
        for (int a = 0; a < 2; ++a)
#pragma unroll
            for (int b = 0; b < 2; ++b)
#pragma unroll
                for (int m = 0; m < 4; ++m)
#pragma unroll
                    for (int n = 0; n < 2; ++n) acc[a][b][m][n] = (f32x4){0.f, 0.f, 0.f, 0.f};
        cur = nxt; cA = nA; cB = nB; ++ui;
    }
    PG8_WAIT_V(0);
    if (wr == 0) PG8_BAR;
    PG8_BAR;
    if constexpr (Epi::AFTER_DRAIN) { E.fused(acc, cur, wr, wc, fr, fq, lds, wid, lane); S.done(cur); }
    PG8_STAMP();
    if (STAMP && wid == 0) { stamps[lane] = lane < nts ? (((unsigned long long)(unsigned)ts_hi << 32) | (unsigned)ts_lo) : 0ull;
        if (lane == 62) stamps[62] = rt_entry; if (lane == 63) stamps[63] = (unsigned long long)wall_clock64(); }
#undef PG8_STAMP
#undef PG8_SA
#undef PG8_SB
#undef PG8_STAGE
#undef PG8_LDA
#undef PG8_LDB
#undef PG8_MMA
#undef PG8_WAIT_V
#undef PG8_WAIT_L
#undef PG8_BAR
#undef PG8_SCHED
}
}

using pg8::bf16_t; using pg8::f32x4; using pg8::u32x4; using pg8::Unit;
#define LAS __attribute__((address_space(3)))
typedef unsigned u32x2 __attribute__((ext_vector_type(2)));
#define DEV __device__ __forceinline__

constexpr int NT = 512, NW = 8;
constexpr int DM = 1024, NB = 8, SQ = 4096, CTX = 256;
constexpr int NCR = NB * CTX;
constexpr int ROWS = NCR + NB * SQ;
constexpr int DFF = 2816, INW = 2832, PST = 2832, NPAD = 3072, NMOD = 6;
constexpr int C_RQ = 0, C_RK = 256, C_RV = 512, C_RG = 768, C_SQ = 1024, C_SK = 1536, C_SV = 1664,
              C_GQ = 1792, C_GK = 2048, C_GV = 2304, C_GZ = 2560, C_GA = 2816, C_GB = 2824;
constexpr int LDS_BYTES = 146 * 1024;

struct Params {
    const float *x, *c, *ctx, *c_ctx, *ada_w, *ada_b, *norm_mix_w, *norm_ffn_w, *w_in, *ret_rate, *ret_norm_w,
        *swa_sinks, *gdn_conv_w, *gdn_a_log, *gdn_dt_bias, *gdn_norm_w, *w_out, *w_ffn_in, *w_ffn_out, *final_norm_w;
    float* XL;
    char* ws;
};

constexpr size_t al256(size_t x) { return (x + 255) & ~(size_t)255; }
constexpr size_t O_XC = 0;
constexpr size_t O_MOD = O_XC + al256((size_t)NCR * DM * 4);
constexpr size_t O_ROPE = O_MOD + al256((size_t)2 * (NB + 1) * NMOD * DM * 4);
constexpr size_t O_WIN = O_ROPE + al256(64 * 16 * 2 * 4 + 64);
constexpr size_t O_WOUT = O_WIN + al256((size_t)2 * NPAD * DM * 2);
constexpr size_t O_WF1 = O_WOUT + al256((size_t)2 * DM * 1024 * 2);
constexpr size_t O_WF2 = O_WF1 + al256((size_t)2 * 2 * DFF * DM * 2);
constexpr size_t O_H = O_WF2 + al256((size_t)2 * DM * DFF * 2);
constexpr size_t O_P = O_H + al256((size_t)ROWS * 1024 * 2);
constexpr size_t O_OG = O_P + al256((size_t)ROWS * PST * 2);
constexpr size_t O_KT = O_OG;
constexpr size_t O_VT = O_KT + al256((size_t)NB * 2 * 68 * 4096 * 2);
constexpr size_t O_RKT = O_VT + al256((size_t)NB * 2 * 68 * 4096 * 2);
constexpr size_t O_RVT = O_RKT + al256((size_t)NB * 4 * 68 * 4096 * 2);
constexpr size_t O_RST = O_RVT + al256((size_t)NB * 4 * 68 * 4096 * 2);
constexpr size_t O_GKT = O_RST + al256((size_t)NB * 4 * 2 * 68 * 4096 * 2);
constexpr size_t O_GUT = O_GKT + al256((size_t)NB * 4 * 2 * 68 * 4096 * 2);
constexpr size_t O_GWN = O_GUT + al256((size_t)NB * 4 * 2 * 68 * 4096 * 2);
constexpr size_t O_GGC = O_GWN + al256((size_t)NB * 4 * 2 * 68 * 4096 * 2);
constexpr size_t O_NWSC = O_GGC + al256((size_t)NB * 4 * 68 * 128 * 4);
constexpr size_t O_BIAS = O_NWSC + al256((size_t)2 * 2 * 9 * 1024 * 4);
constexpr size_t O_SSQ = O_BIAS + al256((size_t)2 * 2 * 9 * 5632 * 4);
constexpr size_t O_BAR = O_SSQ + al256((size_t)ROWS * 16 * 4);
constexpr size_t BAR_BYTES = 3456 * 4 + 256;
constexpr size_t O_CTR = O_BAR + 3456 * 4;
constexpr size_t WS_END = O_BAR + al256(BAR_BYTES);
#define GAS __attribute__((address_space(1)))
#define CAS __attribute__((address_space(4)))
struct DParams {
    GAS const float *x, *c, *ctx, *c_ctx, *ada_w, *ada_b, *norm_mix_w, *norm_ffn_w, *w_in, *ret_rate, *ret_norm_w,
        *swa_sinks, *gdn_conv_w, *gdn_a_log, *gdn_dt_bias, *gdn_norm_w, *w_out, *w_ffn_in, *w_ffn_out, *final_norm_w;
    GAS float* XL;
    GAS char* ws;
};
DEV DParams load_params() {
    const CAS unsigned long long* kp = (const CAS unsigned long long*)__builtin_amdgcn_kernarg_segment_ptr();
    asm volatile("" : "+s"(kp));
    DParams r;
    r.x = (GAS const float*)kp[0]; r.c = (GAS const float*)kp[1]; r.ctx = (GAS const float*)kp[2]; r.c_ctx = (GAS const float*)kp[3];
    r.ada_w = (GAS const float*)kp[4]; r.ada_b = (GAS const float*)kp[5]; r.norm_mix_w = (GAS const float*)kp[6]; r.norm_ffn_w = (GAS const float*)kp[7];
    r.w_in = (GAS const float*)kp[8]; r.ret_rate = (GAS const float*)kp[9]; r.ret_norm_w = (GAS const float*)kp[10]; r.swa_sinks = (GAS const float*)kp[11];
    r.gdn_conv_w = (GAS const float*)kp[12]; r.gdn_a_log = (GAS const float*)kp[13]; r.gdn_dt_bias = (GAS const float*)kp[14]; r.gdn_norm_w = (GAS const float*)kp[15];
    r.w_out = (GAS const float*)kp[16]; r.w_ffn_in = (GAS const float*)kp[17]; r.w_ffn_out = (GAS const float*)kp[18]; r.final_norm_w = (GAS const float*)kp[19];
    r.XL = (GAS float*)kp[20]; r.ws = (GAS char*)kp[21];
    return r;
}
template <class T> DEV T* lp(GAS T* q) { return (T*)q; }
#define WSP(T, name, OFF) DEV T* name(const DParams& p) { return (T*)(lp(p.ws) + (OFF)); }
WSP(float, XC_, O_XC) WSP(float, MOD_, O_MOD) WSP(float, ROPE_, O_ROPE) WSP(bf16_t, WIN_, O_WIN) WSP(bf16_t, WOUT_, O_WOUT) WSP(bf16_t, WF1_, O_WF1)
WSP(bf16_t, WF2_, O_WF2) WSP(bf16_t, H_, O_H) WSP(bf16_t, P_, O_P)  WSP(bf16_t, KT_, O_KT) WSP(bf16_t, VT_, O_VT) WSP(bf16_t, RKT_, O_RKT) WSP(bf16_t, RVT_, O_RVT) WSP(bf16_t, RST_, O_RST) WSP(bf16_t, GKT_, O_GKT) WSP(bf16_t, GUT_, O_GUT) WSP(bf16_t, GWN_, O_GWN) WSP(float, GGC_, O_GGC) WSP(float, NWSC_, O_NWSC) WSP(float, BIAS_, O_BIAS) WSP(float, SSQ_, O_SSQ) WSP(bf16_t, A2_, O_RKT)

DEV int lane_id() { unsigned m = ~0u; asm volatile("" : "+s"(m)); return (int)__builtin_amdgcn_mbcnt_hi(m, __builtin_amdgcn_mbcnt_lo(m, 0u)); }
DEV int launder_s(int v) { asm volatile("" : "+s"(v)); return v; }
DEV int get_tid(int wave_s) { return launder_s(wave_s) * 64 + lane_id(); }
#define XB_TMO      128
#define XB_XCNT(j)  (256  + 64 * (j))
#define XB_XSUB(j)  (1280 + 64 * (j))
#define XB_XGEN(j)  (2304 + 64 * (j))
#define XB_TOP      3328
#define XB_TOPGEN   3392
#define XCD_BAR_WORDS 3456
#define XB_SPIN_CAP (1u << 18)

__device__ __forceinline__ unsigned xb_ld(unsigned* p)              { return __hip_atomic_load(p, __ATOMIC_RELAXED, __HIP_MEMORY_SCOPE_AGENT); }
__device__ __forceinline__ unsigned xb_add(unsigned* p, unsigned v) { return __hip_atomic_fetch_add(p, v, __ATOMIC_RELAXED, __HIP_MEMORY_SCOPE_AGENT); }
__device__ __forceinline__ unsigned xb_xcc_id() { return (unsigned)__builtin_amdgcn_s_getreg((3 << 11) | 20) & 0xFu; }
#define XB_SPIN(cond, bar) do { unsigned _sp = 0; while (cond) { __builtin_amdgcn_s_sleep(1); \
    if ((++_sp & 255u) == 0u) { if (xb_ld(&(bar)[XB_TMO])) break; if (_sp > XB_SPIN_CAP) { atomicAdd(&(bar)[XB_TMO], 1u); break; } } } } while (0)

struct XcdBarrier {
    unsigned* bar; unsigned x;
    volatile LAS unsigned* st;
};

__device__ __forceinline__ XcdBarrier xcd_barrier_post(unsigned* bar, volatile LAS unsigned* st, int tid) {
    XcdBarrier b; b.bar = bar; b.x = xb_xcc_id(); b.st = st;
    if (tid == 0) (void)xb_add(&bar[XB_XCNT(b.x)], 1u);
    return b;
}
__device__ __forceinline__ void xcd_barrier_complete(unsigned* bar, unsigned x, unsigned& nloc, unsigned& nx) {
    const unsigned G = gridDim.x * gridDim.y * gridDim.z;
    unsigned sum, cnt, mine, sp = 0u;
    for (;;) {
        sum = 0u; cnt = 0u; mine = 0u;
#pragma unroll
        for (unsigned j = 0; j < 16; ++j) { const unsigned c = xb_ld(&bar[XB_XCNT(j)]); sum += c; cnt += (c > 0u) ? 1u : 0u; mine = (j == x) ? c : mine; }
        if (sum == G) break;
        __builtin_amdgcn_s_sleep(1);
        if ((++sp & 255u) == 0u) { if (xb_ld(&bar[XB_TMO])) break; if (sp > XB_SPIN_CAP) { atomicAdd(&bar[XB_TMO], 1u); break; } }
    }
    nloc = mine > 0u ? mine : 1u; nx = cnt > 0u ? cnt : 1u;
}

__device__ __forceinline__ void xcd_barrier(const XcdBarrier& b, int tid) {
    asm volatile("s_waitcnt vmcnt(0)" ::: "memory");
    __syncthreads();
    if (tid == 0) {
        unsigned* bar = b.bar; asm volatile("" : "+s"(bar)); unsigned bx = b.x; asm volatile("" : "+s"(bx));
        __builtin_amdgcn_s_waitcnt(0);
        unsigned nloc = b.st[0], nx = b.st[1];
        if (nloc == 0u) { xcd_barrier_complete(bar, bx, nloc, nx); b.st[0] = nloc; b.st[1] = nx; }
        const unsigned old = xb_add(&bar[XB_XSUB(bx)], 1u);
        const unsigned gen = old / nloc;
        if (old + 1u == (gen + 1u) * nloc) {
            __builtin_amdgcn_fence(__ATOMIC_RELEASE, "agent");
            asm volatile("s_waitcnt vmcnt(0)" ::: "memory");
            const unsigned og = xb_add(&bar[XB_TOP], 1u);
            const unsigned tg = og / nx;
            if (og + 1u == (tg + 1u) * nx) xb_add(&bar[XB_TOPGEN], 1u);
            else XB_SPIN(xb_ld(&bar[XB_TOPGEN]) == tg, bar);
            __builtin_amdgcn_fence(__ATOMIC_ACQUIRE, "agent");
            xb_add(&bar[XB_XGEN(bx)], 1u);
            asm volatile("s_waitcnt vmcnt(0)" ::: "memory");
        } else {
            XB_SPIN(xb_ld(&bar[XB_XGEN(bx)]) == gen, bar);
            __builtin_amdgcn_fence(__ATOMIC_ACQUIRE, "agent");
            asm volatile("s_waitcnt vmcnt(0)" ::: "memory");
        }
    }
    __syncthreads();
}

DEV float bf2f(bf16_t v) { return __uint_as_float(((unsigned)v) << 16); }
typedef __bf16 bf16v2 __attribute__((ext_vector_type(2)));
typedef float f32v2 __attribute__((ext_vector_type(2)));
DEV unsigned pkbf(float lo, float hi) { f32v2 v = {lo, hi}; return __builtin_bit_cast(unsigned, __builtin_convertvector(v, bf16v2)); }
DEV bf16_t f2bf(float f) { return (bf16_t)(pkbf(f, 0.f) & 0xffffu); }
DEV unsigned pk2(float lo, float hi) { return pkbf(lo, hi); }
DEV float siluf(float x) { return x * __builtin_amdgcn_rcpf(1.0f + __expf(-x)); }
DEV float sigmf(float x) { return __builtin_amdgcn_rcpf(1.0f + __expf(-x)); }
DEV float softplusf(float x) {
    const float t = __expf(-fabsf(x));
    const float l1p = t < 0.03125f ? t * (1.0f - t * (0.5f - t * (1.0f / 3.0f - 0.25f * t))) : __logf(1.0f + t);
    return fmaxf(x, 0.f) + l1p;
}
template <int CTRL> DEV float dpp_add(float v) {
    const int iv = __float_as_int(v);
    return v + __int_as_float(__builtin_amdgcn_update_dpp(iv, iv, CTRL, 0xF, 0xF, false));
}
DEV float wave_sum(float v) {
    v = dpp_add<0xB1>(v);
    v = dpp_add<0x4E>(v);
    v = dpp_add<0x141>(v);
    v = dpp_add<0x140>(v);
    const int iv = __float_as_int(v);
    return (__int_as_float(__builtin_amdgcn_readlane(iv, 0)) + __int_as_float(__builtin_amdgcn_readlane(iv, 16))) +
           (__int_as_float(__builtin_amdgcn_readlane(iv, 32)) + __int_as_float(__builtin_amdgcn_readlane(iv, 48)));
}
DEV int modrow(int R) { return R < NCR ? NB : (R - NCR) / SQ; }

DEV void transpose_block(const float* W, int K, int N, bf16_t* WT, int drow0, int k0, int n0, LAS float* tile, int tid) {
    {
        const int kq = tid >> 5, n4 = (tid & 31) * 4;
        const bool ok = n0 + n4 < N;
        const float* src = W + (size_t)(k0 + kq) * N + n0 + n4;
        f32x4 v[8];
#pragma unroll
        for (int i = 0; i < 8; ++i) v[i] = ok ? *(const f32x4*)(src + (size_t)(16 * i) * N) : (f32x4){0.f, 0.f, 0.f, 0.f};
#pragma unroll
        for (int i = 0; i < 8; ++i) { LAS float* d = tile + (16 * i + kq) * 129 + n4; d[0] = v[i].x; d[1] = v[i].y; d[2] = v[i].z; d[3] = v[i].w; }
    }
    __syncthreads();
    {
        const int c = tid & 15;
#pragma unroll
        for (int j = 0; j < 4; ++j) {
            const int n = (tid >> 4) + 32 * j;
            const LAS float* sp = tile + (8 * c) * 129 + n;
            u32x4 o;
            o.x = pk2(sp[0 * 129], sp[1 * 129]); o.y = pk2(sp[2 * 129], sp[3 * 129]); o.z = pk2(sp[4 * 129], sp[5 * 129]); o.w = pk2(sp[6 * 129], sp[7 * 129]);
            *(u32x4*)(WT + (size_t)(drow0 + n) * K + k0 + 8 * c) = o;
        }
    }
    __syncthreads();
}

DEV void ph_prologue(const DParams& p, LAS unsigned char* lds, int wave_s) {
    wave_s = launder_s(wave_s);
    const int tid = get_tid(wave_s), lane = tid & 63, wave = tid >> 6;
    const long gtid = (long)blockIdx.x * NT + tid, gsize = (long)gridDim.x * NT;
    {
        LAS float* cs = (LAS float*)lds;
        LAS float* red = (LAS float*)(lds + 9 * 1024 * 4);
        for (int i = tid; i < 9 * DM; i += NT) { const int r = i / DM, k = i % DM; cs[i] = siluf(r < NB ? p.c[r * DM + k] : lp(p.c_ctx)[k]); }
        __syncthreads();
        for (int task = blockIdx.x; task < 2 * 96; task += gridDim.x) {
            const int l = task / 96, col = (task % 96) * 64 + lane;
            const float* w = lp(p.ada_w) + (size_t)l * DM * NMOD * DM + col;
            float acc[9];
#pragma unroll
            for (int r = 0; r < 9; ++r) acc[r] = 0.f;
#pragma unroll 16
            for (int k = wave * 128; k < wave * 128 + 128; ++k) {
                const float wv = w[(size_t)k * NMOD * DM];
#pragma unroll
                for (int r = 0; r < 9; ++r) acc[r] += cs[r * DM + k] * wv;
            }
#pragma unroll
            for (int r = 0; r < 9; ++r) red[(wave * 9 + r) * 64 + lane] = acc[r];
            __syncthreads();
            for (int i = tid; i < 9 * 64; i += NT) {
                const int r = i / 64, cc = i % 64;
                float s = 0.f;
                for (int w8 = 0; w8 < 8; ++w8) s += red[(w8 * 9 + r) * 64 + cc];
                const int colg = (task % 96) * 64 + cc;
                MOD_(p)[((size_t)l * (NB + 1) + r) * NMOD * DM + colg] = s + lp(p.ada_b)[(size_t)l * NMOD * DM + colg];
            }
            __syncthreads();
        }
    }
    {
        if (gtid < 16) { const float rate = lp(p.ret_rate)[gtid]; ROPE_(p)[64 * 16 * 2 + gtid] = log1pf(-exp2f(-rate)) * 1.44269504088896f; }
        for (long i = gtid; i < 64 * 16; i += gsize) {
            const int pos = (int)(i / 16), f = (int)(i % 16);
            const double fr = pow(10000.0, -(double)f / 16.0), ang = (double)pos * fr;
            ROPE_(p)[i * 2 + 0] = (float)cos(ang); ROPE_(p)[i * 2 + 1] = (float)sin(ang);
        }
    }
    {
        LAS float* tile = (LAS float*)lds;
        unsigned* ctr = (unsigned*)(lp(p.ws) + O_CTR) + 32;
        volatile LAS unsigned* slot = (volatile LAS unsigned*)(lds + LDS_BYTES - 32);
        constexpr int I_IN = 8 * 24, I_OUT = 8 * 8, I_F1 = 8 * 44, I_F2 = 22 * 8, I_L = I_IN + I_OUT + I_F1 + I_F2;
        for (;;) {
            if (tid == 0) slot[0] = atomicAdd(ctr, 1u);
            __syncthreads();
            const int it = (int)slot[0];
            __syncthreads();
            if (it >= 2 * I_L) break;
            const int l = it / I_L; int r = it % I_L;
            if (r < I_IN) { const int kb = r / 24, nb = r % 24; transpose_block(lp(p.w_in) + (size_t)l * DM * INW, DM, INW, WIN_(p) + (size_t)l * NPAD * DM, nb * 128, kb * 128, nb * 128, tile, tid); continue; }
            r -= I_IN;
            if (r < I_OUT) { const int kb = r / 8, nb = r % 8; transpose_block(lp(p.w_out) + (size_t)l * 1024 * DM, 1024, DM, WOUT_(p) + (size_t)l * DM * 1024, nb * 128, kb * 128, nb * 128, tile, tid); continue; }
            r -= I_OUT;
            if (r < I_F1) {
                const int kb = r / 44, nb = r % 44, n0 = nb * 128;
                const int j = n0 < DFF ? n0 : n0 - DFF;
                const int drow = 256 * (j / 128) + (n0 < DFF ? 0 : 128);
                transpose_block(lp(p.w_ffn_in) + (size_t)l * DM * 2 * DFF, DM, 2 * DFF, WF1_(p) + (size_t)l * 2 * DFF * DM, drow, kb * 128, n0, tile, tid); continue;
            }
            r -= I_F1;
            { const int kb = r / 8, nb = r % 8; transpose_block(lp(p.w_ffn_out) + (size_t)l * DFF * DM, DFF, DM, WF2_(p) + (size_t)l * DM * DFF, nb * 128, kb * 128, nb * 128, tile, tid); }
        }
    }
}

DEV void ph_pre0(const DParams& p, LAS unsigned char* lds, int wave_s) {
    wave_s = launder_s(wave_s);
    const int tid = get_tid(wave_s), lane = tid & 63;
    const long gtid = (long)blockIdx.x * NT + tid, gsize = (long)gridDim.x * NT;
    for (long i = gtid; i < 2 * 2 * 9 * DM; i += gsize) {
        const int k = (int)(i % DM), m = (int)((i / DM) % 9), which = (int)((i / (9 * DM)) % 2), l = (int)(i / (2 * 9 * DM));
        const float nw = (which == 0 ? lp(p.norm_mix_w) : lp(p.norm_ffn_w))[l * DM + k];
        const float sc = MOD_(p)[((size_t)l * (NB + 1) + m) * NMOD * DM + (which == 0 ? 1 : 4) * DM + k];
        NWSC_(p)[i] = nw * (1.0f + sc);
    }
    {
        LAS float* shs = (LAS float*)lds;
        for (int vb = blockIdx.x; vb < 256; vb += gridDim.x) {
            const int l = vb >> 7, bb = vb & 127, which = bb < 43 ? 0 : 1, sub = which == 0 ? bb : bb - 43, nsub = which == 0 ? 43 : 85;
            const int N = which == 0 ? NPAD : 2 * DFF;
            const int c0 = (int)((long)N * sub / nsub), c1 = (int)((long)N * (sub + 1) / nsub);
            const bf16_t* Wt = which == 0 ? WIN_(p) + (size_t)l * NPAD * DM : WF1_(p) + (size_t)l * 2 * DFF * DM;
            __syncthreads();
            for (int i = tid; i < 9 * DM; i += NT) shs[i] = MOD_(p)[((size_t)l * (NB + 1) + i / DM) * NMOD * DM + (which == 0 ? 0 : 3) * DM + (i % DM)];
            __syncthreads();
            float sh[9][16];
#pragma unroll
            for (int m = 0; m < 9; ++m)
#pragma unroll
                for (int q = 0; q < 4; ++q) {
                    const f32x4 t4 = *(const LAS f32x4*)(shs + m * DM + (q >> 1) * 512 + 8 * lane + 4 * (q & 1));
                    sh[m][4 * q + 0] = t4.x; sh[m][4 * q + 1] = t4.y; sh[m][4 * q + 2] = t4.z; sh[m][4 * q + 3] = t4.w;
                }
            float* bo = BIAS_(p) + ((size_t)l * 2 + which) * 9 * 5632;
            for (int n = c0 + wave_s; n < c1; n += NW) {
                const u32x4 w0 = *(const u32x4*)(Wt + (size_t)n * DM + 8 * lane), w1 = *(const u32x4*)(Wt + (size_t)n * DM + 512 + 8 * lane);
                float wv[16];
#pragma unroll
                for (int j = 0; j < 4; ++j) { wv[2 * j] = __uint_as_float(w0[j] << 16); wv[2 * j + 1] = __uint_as_float(w0[j] & 0xffff0000u); wv[8 + 2 * j] = __uint_as_float(w1[j] << 16); wv[8 + 2 * j + 1] = __uint_as_float(w1[j] & 0xffff0000u); }
                float acc[9];
#pragma unroll
                for (int m = 0; m < 9; ++m) {
                    float a = 0.f;
#pragma unroll
                    for (int j = 0; j < 16; ++j) a += sh[m][j] * wv[j];
                    acc[m] = wave_sum(a);
                }
                if (lane < 9) {
                    float v = acc[0];
#pragma unroll
                    for (int m = 1; m < 9; ++m) v = lane == m ? acc[m] : v;
                    bo[(size_t)lane * 5632 + n] = v;
                }
            }
        }
        __syncthreads();
    }
    {
        const int gw = blockIdx.x * NW + wave_s, ngw = gridDim.x * NW;
        const float* nw = lp(p.norm_mix_w);
        for (int R = gw; R < ROWS; R += ngw) {
            const f32x4* xr = (const f32x4*)(R < NCR ? lp(p.ctx) + (size_t)R * DM : lp(p.x) + (size_t)(R - NCR) * DM) + lane;
            f32x4 v[4]; float sq = 0.f;
#pragma unroll
            for (int j = 0; j < 4; ++j) { v[j] = xr[64 * j]; sq += (v[j].x * v[j].x + v[j].y * v[j].y) + (v[j].z * v[j].z + v[j].w * v[j].w); }
            sq = wave_sum(sq);
            const f32x4* sc = (const f32x4*)(MOD_(p) + (size_t)modrow(R) * NMOD * DM + 1 * DM) + lane;
            const f32x4* w4 = (const f32x4*)nw + lane;
            unsigned long long* o8 = (unsigned long long*)(H_(p) + (size_t)R * DM) + lane;
#pragma unroll
            for (int j = 0; j < 4; ++j) {
                const f32x4 a = v[j] * w4[64 * j] * (sc[64 * j] + 1.0f);
                o8[64 * j] = (unsigned long long)pk2(a.x, a.y) | ((unsigned long long)pk2(a.z, a.w) << 32);
            }
            if (lane < 16) SSQ_(p)[(size_t)R * 16 + lane] = lane == 0 ? sq : 0.f;
        }
    }
}

DEV float shfl_xor_l(float v, int m) { return __int_as_float(__builtin_amdgcn_ds_bpermute((lane_id() ^ m) << 2, __float_as_int(v))); }
DEV void rows_rstd(const float* ssq, int R0, int fq, float (&rs)[2][4]) {
    f32x4 q[2][4];
#pragma unroll
    for (int ai = 0; ai < 2; ++ai)
#pragma unroll
        for (int m = 0; m < 4; ++m) q[ai][m] = *(const f32x4*)(ssq + (size_t)(R0 + ai * 128 + m * 16) * 16 + 4 * fq);
#pragma unroll
    for (int ai = 0; ai < 2; ++ai)
#pragma unroll
        for (int m = 0; m < 4; ++m) {
            float a = (q[ai][m].x + q[ai][m].y) + (q[ai][m].z + q[ai][m].w);
            a += shfl_xor_l(a, 16); a += shfl_xor_l(a, 32);
            rs[ai][m] = __builtin_amdgcn_rsqf(a * (1.0f / DM) + 1e-6f);
        }
}
struct EpiP {
    static constexpr bool PERM = true, AFTER_DRAIN = false;
    bf16_t* O; int ldc; const float* ssq; const float* bias;
    DEV void operator()(const f32x4 (&acc)[2][2][4][2], const Unit& u, int wr, int wc, int fr, int fq) const {
        const int row0 = u.pm * 256 + wr * 64 + fr, col0 = u.pn * 256 + wc * 32 + 8 * fq;
        const float* bp = bias + (size_t)modrow(u.pm * 256) * 5632 + col0;
        f32x4 bv[2][2];
#pragma unroll
        for (int bj = 0; bj < 2; ++bj)
#pragma unroll
            for (int n = 0; n < 2; ++n) bv[bj][n] = *(const f32x4*)(bp + bj * 128 + 4 * n);
        float rs[2][4];
        rows_rstd(ssq, row0, fq, rs);
#pragma unroll
        for (int ai = 0; ai < 2; ++ai)
#pragma unroll
            for (int m = 0; m < 4; ++m) {
                bf16_t* rowp = O + (size_t)(row0 + ai * 128 + m * 16) * ldc + col0;
#pragma unroll
                for (int bj = 0; bj < 2; ++bj) {
                    const f32x4 v0 = acc[ai][bj][m][0] * rs[ai][m] + bv[bj][0], v1 = acc[ai][bj][m][1] * rs[ai][m] + bv[bj][1];
                    u32x4 w; w.x = pg8::cvt_pk_bf16(v0[0], v0[1]); w.y = pg8::cvt_pk_bf16(v0[2], v0[3]); w.z = pg8::cvt_pk_bf16(v1[0], v1[1]); w.w = pg8::cvt_pk_bf16(v1[2], v1[3]);
                    if (col0 + bj * 128 < INW) *(u32x4*)(rowp + bj * 128) = w;
                }
            }
    }
};
struct EpiSwiglu {
    static constexpr bool PERM = true, AFTER_DRAIN = false;
    bf16_t* O; int ldc; const float* ssq; const float* bias; int row_base;
    DEV void operator()(const f32x4 (&acc)[2][2][4][2], const Unit& u, int wr, int wc, int fr, int fq) const {
        const int row0 = u.pm * 256 + wr * 64 + fr, col0 = u.pn * 128 + wc * 32 + 8 * fq;
        const float* bp = bias + (size_t)modrow(row_base + u.pm * 256) * 5632 + u.pn * 256 + wc * 32 + 8 * fq;
        f32x4 bg[2], bu[2];
#pragma unroll
        for (int n = 0; n < 2; ++n) { bg[n] = *(const f32x4*)(bp + 4 * n); bu[n] = *(const f32x4*)(bp + 128 + 4 * n); }
        float rs[2][4];
        rows_rstd(ssq, row_base + row0, fq, rs);
#pragma unroll
        for (int ai = 0; ai < 2; ++ai)
#pragma unroll
            for (int m = 0; m < 4; ++m) {
                bf16_t* rowp = O + (size_t)(row0 + ai * 128 + m * 16) * ldc + col0;
                float v[8];
#pragma unroll
                for (int n = 0; n < 2; ++n)
#pragma unroll
                    for (int i = 0; i < 4; ++i) { const float g = acc[ai][0][m][n][i] * rs[ai][m] + bg[n][i], up = acc[ai][1][m][n][i] * rs[ai][m] + bu[n][i]; v[n * 4 + i] = g * __builtin_amdgcn_rcpf(1.0f + __expf(-g)) * up; }
                u32x4 w; w.x = pg8::cvt_pk_bf16(v[0], v[1]); w.y = pg8::cvt_pk_bf16(v[2], v[3]); w.z = pg8::cvt_pk_bf16(v[4], v[5]); w.w = pg8::cvt_pk_bf16(v[6], v[7]);
                *(u32x4*)rowp = w;
            }
    }
};
struct EpiRes {
    static constexpr bool PERM = true, AFTER_DRAIN = false;
    const float* SL; const float* SC; float* XL; float* XC; const float* modl; int gidx; int row_base;
    const float* nwsc;
    bf16_t* An;
    float* ssq;
    DEV void operator()(const f32x4 (&acc)[2][2][4][2], const Unit& u, int wr, int wc, int fr, int fq) const {
        const int row0 = row_base + u.pm * 256 + wr * 64 + fr, col0 = u.pn * 256 + wc * 32 + 8 * fq;
        const int mr = modrow(row_base + u.pm * 256);
        const float* g = modl + (size_t)mr * NMOD * DM + gidx * DM + col0;
        const bool isc = (row_base + u.pm * 256) < NCR;
        const size_t xb = (isc ? (size_t)row0 * DM : (size_t)(row0 - NCR) * DM) + col0;
        const float* xs = (isc ? SC : SL) + xb;
        float* xd = (isc ? XC : XL) + xb;
        f32x4 gv[2][2], nv[2][2];
#pragma unroll
        for (int bj = 0; bj < 2; ++bj)
#pragma unroll
            for (int n = 0; n < 2; ++n) {
                gv[bj][n] = *(const f32x4*)(g + bj * 128 + n * 4);
                nv[bj][n] = nwsc ? *(const f32x4*)(nwsc + (size_t)mr * DM + col0 + bj * 128 + n * 4) : (f32x4){0.f, 0.f, 0.f, 0.f};
            }
#pragma unroll
        for (int am = 0; am < 4; ++am) {
            const int ai = am >> 1, m0 = (am & 1) * 2;
            f32x4 xo[2][2][2];
#pragma unroll
            for (int mm = 0; mm < 2; ++mm)
#pragma unroll
                for (int bj = 0; bj < 2; ++bj)
#pragma unroll
                    for (int n = 0; n < 2; ++n) xo[mm][bj][n] = *(const f32x4*)(xs + (size_t)(ai * 128 + (m0 + mm) * 16) * DM + bj * 128 + n * 4);
            asm volatile("" ::: "memory");
#pragma unroll
            for (int mm = 0; mm < 2; ++mm) {
                const int m = m0 + mm;
                const int R = row0 + ai * 128 + m * 16;
                const size_t ro = (size_t)(ai * 128 + m * 16) * DM;
                float sq = 0.f;
#pragma unroll
                for (int bj = 0; bj < 2; ++bj) {
                    const f32x4 x0 = xo[mm][bj][0] + gv[bj][0] * acc[ai][bj][m][0], x1 = xo[mm][bj][1] + gv[bj][1] * acc[ai][bj][m][1];
                    *(f32x4*)(xd + ro + bj * 128) = x0; *(f32x4*)(xd + ro + bj * 128 + 4) = x1;
                    sq += ((x0.x * x0.x + x0.y * x0.y) + (x0.z * x0.z + x0.w * x0.w)) + ((x1.x * x1.x + x1.y * x1.y) + (x1.z * x1.z + x1.w * x1.w));
                    if (nwsc) {
                        const f32x4 a0 = x0 * nv[bj][0], a1 = x1 * nv[bj][1];
                        u32x4 w; w.x = pg8::cvt_pk_bf16(a0.x, a0.y); w.y = pg8::cvt_pk_bf16(a0.z, a0.w); w.z = pg8::cvt_pk_bf16(a1.x, a1.y); w.w = pg8::cvt_pk_bf16(a1.z, a1.w);
                        *(u32x4*)(An + (size_t)R * DM + col0 + bj * 128) = w;
                    }
                }
                sq += shfl_xor_l(sq, 16); sq += shfl_xor_l(sq, 32);
                if (fq == 0) ssq[(size_t)R * 16 + u.pn * 4 + wc] = sq;
            }
        }
    }
};

typedef float f32x16 __attribute__((ext_vector_type(16)));
using pg8::bf16x8;
#define MFMA32(a, b, c) __builtin_amdgcn_mfma_f32_32x32x16_bf16((a), (b), (c), 0, 0, 0)
DEV float bflo(unsigned w) { return __uint_as_float(w << 16); }
DEV float bfhi(unsigned w) { return __uint_as_float(w & 0xffff0000u); }
DEV float xor32_max(float v) { const auto r = __builtin_amdgcn_permlane32_swap(__float_as_uint(v), __float_as_uint(v), false, false); return fmaxf(__uint_as_float(r[0]), __uint_as_float(r[1])); }
DEV float xor32_sum(float v) { const auto r = __builtin_amdgcn_permlane32_swap(__float_as_uint(v), __float_as_uint(v), false, false); return __uint_as_float(r[0]) + __uint_as_float(r[1]); }
DEV float shfl_xor32(float v) { const int idx = (lane_id() ^ 32) << 2; return __int_as_float(__builtin_amdgcn_ds_bpermute(idx, __float_as_int(v))); }
#define LDS_BARRIER() do { asm volatile("s_waitcnt lgkmcnt(0)" ::: "memory"); __builtin_amdgcn_s_barrier(); asm volatile("" ::: "memory"); } while (0)
DEV int kswz(int r) { return (r & ~12) | ((r & 4) << 1) | ((r & 8) >> 1); }

DEV void swa_unit(const DParams& p, int layer, int unit, LAS unsigned char* lds, int tid, int wave_s) {
    const bool lat = unit < NB * 2 * 64;
    int b, kvh, qb;
    if (lat) { b = unit / 128; kvh = (unit / 64) & 1; qb = unit % 64; }
    else { const int u = unit - NB * 2 * 64; b = u / 8; kvh = (u / 4) & 1; qb = u % 4; }
    const int lt_lo = lat ? (qb - 2 < 0 ? 0 : qb - 2) : 0, lt_hi = lat ? (qb + 2 > 63 ? 63 : qb + 2) : -1;
    const int nt = 4 + (lt_hi - lt_lo + 1);
    {
        const bf16_t* kt = KT_(p) + (size_t)(b * 2 + kvh) * 68 * 4096;
        const bf16_t* vt = VT_(p) + (size_t)(b * 2 + kvh) * 68 * 4096;
        for (int i = 0; i < nt; ++i) {
            const int tile = i < 4 ? i : 4 + lt_lo + (i - 4);
            const u32x4 kq = *(const u32x4*)(kt + (size_t)tile * 4096 + tid * 8);
            const u32x4 vq = *(const u32x4*)(vt + (size_t)tile * 4096 + tid * 8);
            *(LAS u32x4*)(lds + i * 16384 + tid * 16) = kq;
            *(LAS u32x4*)(lds + i * 16384 + 8192 + tid * 16) = vq;
        }
    }
    __syncthreads();
    const int lane = tid & 63, r = lane & 31, h = lane >> 5;
    const int g = wave_s >> 1, sb = wave_s & 1, hq = kvh * 4 + g;
    const int qloc = qb * 64 + 32 * sb + r;
    const int qrow = lat ? NCR + b * SQ + qloc : b * CTX + qloc;
    bf16x8 qf[4];
    {
        const bf16_t* qp = P_(p) + (size_t)qrow * PST + C_SQ + hq * 64 + 8 * h;
        float qv[4][8];
#pragma unroll
        for (int s4 = 0; s4 < 4; ++s4) {
            const u32x4 w = *(const u32x4*)(qp + 16 * s4);
#pragma unroll
            for (int j = 0; j < 8; ++j) qv[s4][j] = (j & 1) ? bfhi(w[j >> 1]) : bflo(w[j >> 1]);
        }
        if (lat) {
#pragma unroll
            for (int a = 0; a < 2; ++a) {
                const int pos = a == 0 ? qloc / 64 : qloc % 64;
                const float* rp = ROPE_(p) + (pos * 16 + 8 * h) * 2;
#pragma unroll
                for (int j = 0; j < 8; ++j) {
                    const float cs = rp[2 * j], sn = rp[2 * j + 1], t1 = qv[2 * a][j], t2 = qv[2 * a + 1][j];
                    qv[2 * a][j] = t1 * cs - t2 * sn; qv[2 * a + 1][j] = t1 * sn + t2 * cs;
                }
            }
        }
        const float qs = 0.125f * 1.44269504088896f;
#pragma unroll
        for (int s4 = 0; s4 < 4; ++s4) {
            u32x4 w;
            w.x = pkbf(qv[s4][0] * qs, qv[s4][1] * qs); w.y = pkbf(qv[s4][2] * qs, qv[s4][3] * qs);
            w.z = pkbf(qv[s4][4] * qs, qv[s4][5] * qs); w.w = pkbf(qv[s4][6] * qs, qv[s4][7] * qs);
            qf[s4] = __builtin_bit_cast(bf16x8, w);
        }
    }
    f32x16 O0, O1;
#pragma unroll
    for (int i = 0; i < 16; ++i) { O0[i] = 0.f; O1[i] = 0.f; }
    float m = lp(p.swa_sinks)[layer * 8 + hq] * 1.44269504088896f, l = 1.0f;
    const int ksw = ((r >> 1) & 7);
    for (int ti = 0; ti < nt; ++ti) {
        const LAS unsigned char* Kt = lds + ti * 16384;
        const LAS unsigned char* Vt = Kt + 8192;
        f32x16 x0, x1;
#pragma unroll
        for (int i = 0; i < 16; ++i) { x0[i] = 0.f; x1[i] = 0.f; }
#pragma unroll
        for (int s4 = 0; s4 < 4; ++s4) {
            const bf16x8 k0 = *(const LAS bf16x8*)(Kt + r * 128 + (((2 * s4 + h) ^ ksw) * 16));
            const bf16x8 k1 = *(const LAS bf16x8*)(Kt + (32 + r) * 128 + (((2 * s4 + h) ^ ksw) * 16));
            x0 = MFMA32(k0, qf[s4], x0);
            x1 = MFMA32(k1, qf[s4], x1);
        }
        if (ti >= 4) {
            const int lt = lt_lo + (ti - 4);
            if (lt == qb - 2 || lt == qb + 2) {
                const int kbase = lt * 64 + 4 * h - qloc;
#pragma unroll
                for (int i = 0; i < 16; ++i) {
                    const int d0 = kbase + (i & 3) + 8 * (i >> 2), d1 = d0 + 32;
                    if (d0 > 128 || d0 < -128) x0[i] = -1e30f;
                    if (d1 > 128 || d1 < -128) x1[i] = -1e30f;
                }
            }
        }
        float mx = x0[0];
#pragma unroll
        for (int i = 1; i < 16; ++i) mx = fmaxf(mx, x0[i]);
#pragma unroll
        for (int i = 0; i < 16; ++i) mx = fmaxf(mx, x1[i]);
        mx = xor32_max(mx);
        const float mn = fmaxf(m, mx), alpha = __builtin_amdgcn_exp2f(m - mn);
        m = mn;
        float rs = 0.f;
#pragma unroll
        for (int i = 0; i < 16; ++i) { x0[i] = __builtin_amdgcn_exp2f(x0[i] - mn); x1[i] = __builtin_amdgcn_exp2f(x1[i] - mn); rs += x0[i] + x1[i]; }
        rs = xor32_sum(rs);
        l = l * alpha + rs;
#pragma unroll
        for (int i = 0; i < 16; ++i) { O0[i] *= alpha; O1[i] *= alpha; }
#pragma unroll
        for (int kg = 0; kg < 2; ++kg)
#pragma unroll
            for (int s2 = 0; s2 < 2; ++s2) {
                u32x4 w;
                if (kg == 0) { w.x = pkbf(x0[8 * s2 + 0], x0[8 * s2 + 1]); w.y = pkbf(x0[8 * s2 + 2], x0[8 * s2 + 3]); w.z = pkbf(x0[8 * s2 + 4], x0[8 * s2 + 5]); w.w = pkbf(x0[8 * s2 + 6], x0[8 * s2 + 7]); }
                else { w.x = pkbf(x1[8 * s2 + 0], x1[8 * s2 + 1]); w.y = pkbf(x1[8 * s2 + 2], x1[8 * s2 + 3]); w.z = pkbf(x1[8 * s2 + 4], x1[8 * s2 + 5]); w.w = pkbf(x1[8 * s2 + 6], x1[8 * s2 + 7]); }
                const bf16x8 pf = __builtin_bit_cast(bf16x8, w);
                const int ch = 4 * kg + 2 * s2 + h;
                const bf16x8 v0 = *(const LAS bf16x8*)(Vt + r * 128 + ((ch ^ ksw) * 16));
                const bf16x8 v1 = *(const LAS bf16x8*)(Vt + (32 + r) * 128 + ((ch ^ ksw) * 16));
                O0 = MFMA32(v0, pf, O0);
                O1 = MFMA32(v1, pf, O1);
            }
    }
    {
        const float inv = 1.0f / l;
        bf16_t* op = H_(p) + (size_t)qrow * 1024 + 256 + hq * 64 + 4 * h;
#pragma unroll
        for (int g4 = 0; g4 < 4; ++g4) {
            uint2 w0, w1;
            w0.x = pkbf(O0[4 * g4] * inv, O0[4 * g4 + 1] * inv); w0.y = pkbf(O0[4 * g4 + 2] * inv, O0[4 * g4 + 3] * inv);
            w1.x = pkbf(O1[4 * g4] * inv, O1[4 * g4 + 1] * inv); w1.y = pkbf(O1[4 * g4 + 2] * inv, O1[4 * g4 + 3] * inv);
            *(uint2*)(op + 8 * g4) = w0;
            *(uint2*)(op + 32 + 8 * g4) = w1;
        }
    }
    __syncthreads();
}

typedef float f32x4v __attribute__((ext_vector_type(4)));
#define MFMA16(a, b, c) __builtin_amdgcn_mfma_f32_16x16x32_bf16((a), (b), (c), 0, 0, 0)
DEV float ex2(float x) { return __builtin_amdgcn_exp2f(x); }
template <int CTRL> DEV float dpp_mov(float v) { const int iv = __float_as_int(v); return __int_as_float(__builtin_amdgcn_update_dpp(iv, iv, CTRL, 0xF, 0xF, false)); }
DEV float row16_sum(float v) {
    v += dpp_mov<0xB1>(v); v += dpp_mov<0x4E>(v); v += dpp_mov<0x141>(v); v += dpp_mov<0x140>(v); return v;
}
DEV int chunk_row0(int b, int n) { return n < 4 ? b * CTX + n * 64 : NCR + b * SQ + (n - 4) * 64; }
DEV void load_rope8(const DParams& p, const bf16_t* hp, int c, bool lat, int t, float scale, float (&o)[8]) {
    const u32x4 kv = *(const u32x4*)(hp + 8 * c);
#pragma unroll
    for (int j = 0; j < 8; ++j) o[j] = (j & 1) ? bfhi(kv[j >> 1]) : bflo(kv[j >> 1]);
    if (lat) {
        const u32x4 pv = *(const u32x4*)(hp + 8 * (c ^ 2));
        const int pos = (c >> 2) == 0 ? t / 64 : t % 64;
        const float* rp = ROPE_(p) + (pos * 16 + 8 * (c & 1)) * 2;
        const bool first = (c & 2) == 0;
        f32x4 rt[4];
#pragma unroll
        for (int q4 = 0; q4 < 4; ++q4) rt[q4] = *(const f32x4*)(rp + 4 * q4);
#pragma unroll
        for (int j = 0; j < 8; ++j) {
            const float oth = (j & 1) ? bfhi(pv[j >> 1]) : bflo(pv[j >> 1]);
            const float cs = rt[j >> 1][2 * (j & 1)], sn = rt[j >> 1][2 * (j & 1) + 1];
            o[j] = first ? o[j] * cs - oth * sn : oth * sn + o[j] * cs;
        }
    }
#pragma unroll
    for (int j = 0; j < 8; ++j) o[j] *= scale;
}
DEV u32x4 pack8(const float (&o)[8]) { u32x4 w; w.x = pkbf(o[0], o[1]); w.y = pkbf(o[2], o[3]); w.z = pkbf(o[4], o[5]); w.w = pkbf(o[6], o[7]); return w; }

DEV float ret_lg2(const DParams& p, int layer, int dir, int h) { return ROPE_(p)[64 * 16 * 2 + layer * 8 + dir * 4 + h]; }
struct RetOps { u32x4 kw[2]; bf16x8 bq[2][2]; };
DEV int chain_chunk(int dir, int step) { return dir == 0 ? step : (step < 4 ? 3 - step : 67 - (step - 4)); }
DEV void ret_ops_load(RetOps& o, const bf16_t* rkt, const bf16_t* rvt, int bh, int dir, int step, int it, int jt0, int lr, int lq) {
    const size_t rec = (size_t)bh * 68 + chain_chunk(dir, step);
#pragma unroll
    for (int ks = 0; ks < 2; ++ks) {
        o.kw[ks] = *(const u32x4*)(rkt + rec * 4096 + (16 * it + lr) * 64 + 32 * ks + 8 * lq);
#pragma unroll
        for (int t = 0; t < 2; ++t) o.bq[t][ks] = *(const bf16x8*)(rvt + rec * 4096 + (16 * (jt0 + t) + lr) * 64 + 32 * ks + 8 * lq);
    }
}
DEV void ret_scan_chain(const DParams& p, int layer, int chain, int tid, int wave_s) {
    const int dir = chain & 1, bh = chain >> 1, h = bh & 3;
    const int lane = tid & 63, lr = lane & 15, lq = lane >> 4, it = wave_s >> 1, jt0 = 2 * (wave_s & 1);
    const float lg2 = ret_lg2(p, layer, dir, h), g64 = ex2(64.f * lg2);
    float dec[2][8];
#pragma unroll
    for (int ks = 0; ks < 2; ++ks)
#pragma unroll
        for (int j = 0; j < 8; ++j) { const int tok = 32 * ks + 8 * lq + j; dec[ks][j] = ex2(lg2 * (float)(dir == 0 ? 63 - tok : tok)); }
    const bf16_t* rkt = RKT_(p); const bf16_t* rvt = RVT_(p); bf16_t* rst = RST_(p);
    f32x4v S[2];
#pragma unroll
    for (int t = 0; t < 2; ++t) S[t] = (f32x4v){0.f, 0.f, 0.f, 0.f};
    RetOps o0, o1, o2, o3;
    ret_ops_load(o0, rkt, rvt, bh, dir, 0, it, jt0, lr, lq); ret_ops_load(o1, rkt, rvt, bh, dir, 1, it, jt0, lr, lq);
    ret_ops_load(o2, rkt, rvt, bh, dir, 2, it, jt0, lr, lq); ret_ops_load(o3, rkt, rvt, bh, dir, 3, it, jt0, lr, lq);
#define RET_STEP(O, STEP) do { \
        const size_t srec = (size_t)chain * 68 + chain_chunk(dir, (STEP)); \
        _Pragma("unroll") for (int t = 0; t < 2; ++t) { u32x2 w; w.x = pkbf(S[t][0], S[t][1]); w.y = pkbf(S[t][2], S[t][3]); \
            *(u32x2*)(rst + srec * 4096 + (16 * (jt0 + t) + lr) * 64 + 16 * it + 4 * lq) = w; } \
        bf16x8 a_[2]; \
        _Pragma("unroll") for (int ks = 0; ks < 2; ++ks) { float kv[8]; \
            _Pragma("unroll") for (int j = 0; j < 8; ++j) kv[j] = ((j & 1) ? bfhi(O.kw[ks][j >> 1]) : bflo(O.kw[ks][j >> 1])) * dec[ks][j]; \
            a_[ks] = __builtin_bit_cast(bf16x8, pack8(kv)); } \
        _Pragma("unroll") for (int t = 0; t < 2; ++t) { S[t] = S[t] * g64; \
            _Pragma("unroll") for (int ks = 0; ks < 2; ++ks) S[t] = MFMA16(a_[ks], O.bq[t][ks], S[t]); } \
        if ((STEP) + 4 < 68) ret_ops_load(O, rkt, rvt, bh, dir, (STEP) + 4, it, jt0, lr, lq); \
    } while (0)
#pragma unroll
    for (int step = 0; step < 68; step += 4) { RET_STEP(o0, step); RET_STEP(o1, step + 1); RET_STEP(o2, step + 2); RET_STEP(o3, step + 3); }
#undef RET_STEP
}

DEV void gdn_conv8(const float* cw, const bf16_t* hp, int chan, bool hasp, bool hasn, float (&o)[8]) {
    const u32x4 cur = *(const u32x4*)hp;
    u32x4 prv = (u32x4){0u, 0u, 0u, 0u}, nxt = prv;
    if (hasp) prv = *(const u32x4*)(hp - PST);
    if (hasn) nxt = *(const u32x4*)(hp + PST);
    f32x4 w[3][2];
#pragma unroll
    for (int t3 = 0; t3 < 3; ++t3) { w[t3][0] = *(const f32x4*)(cw + t3 * 768 + chan); w[t3][1] = *(const f32x4*)(cw + t3 * 768 + chan + 4); }
#pragma unroll
    for (int j = 0; j < 8; ++j) {
        const float a = ((j & 1) ? bfhi(prv[j >> 1]) : bflo(prv[j >> 1])) * w[0][j >> 2][j & 3] + ((j & 1) ? bfhi(cur[j >> 1]) : bflo(cur[j >> 1])) * w[1][j >> 2][j & 3] +
                        ((j & 1) ? bfhi(nxt[j >> 1]) : bflo(nxt[j >> 1])) * w[2][j >> 2][j & 3];
        o[j] = a * __builtin_amdgcn_rcpf(1.0f + __expf(-a));
    }
}
DEV float oct_sum(float v) { v += dpp_mov<0xB1>(v); v += dpp_mov<0x4E>(v); v += dpp_mov<0x141>(v); return v; }
DEV void l2norm8(float (&o)[8], float extra) {
    float ss = 0.f;
#pragma unroll
    for (int j = 0; j < 8; ++j) ss += o[j] * o[j];
    const float sc = extra * __builtin_amdgcn_rsqf(oct_sum(ss) + 1e-6f);
#pragma unroll
    for (int j = 0; j < 8; ++j) o[j] *= sc;
}


struct GdnPre { u32x4 kc[3], vc[3]; float ga, gb; };
DEV void gdn_pre_load(GdnPre& o, const DParams& p, int task, int tid) {
    const int n = task % 68, bh = task / 68, b = bh >> 2, h = bh & 3;
    const int row0 = chunk_row0(b, n), r = tid >> 3, c = tid & 7;
    const int slen = n < 4 ? CTX : SQ, t0 = n < 4 ? n * 64 : (n - 4) * 64;
    const bf16_t* prow = P_(p) + (size_t)(row0 + r) * PST;
    const bool hasp = t0 + r > 0, hasn = t0 + r + 1 < slen;
    const u32x4 z = (u32x4){0u, 0u, 0u, 0u};
    const bf16_t* kp = prow + C_GK + h * 64 + 8 * c;
    const bf16_t* vp = prow + C_GV + h * 64 + 8 * c;
    o.kc[1] = *(const u32x4*)kp; o.vc[1] = *(const u32x4*)vp;
    o.kc[0] = z; o.vc[0] = z; o.kc[2] = z; o.vc[2] = z;
    if (hasp) { o.kc[0] = *(const u32x4*)(kp - PST); o.vc[0] = *(const u32x4*)(vp - PST); }
    if (hasn) { o.kc[2] = *(const u32x4*)(kp + PST); o.vc[2] = *(const u32x4*)(vp + PST); }
    o.ga = 0.f; o.gb = 0.f;
    if (tid < 128) {
        const int dir = tid >> 6, i = tid & 63;
        const bf16_t* pr = P_(p) + (size_t)(row0 + i) * PST;
        o.ga = bf2f(pr[C_GA + dir * 4 + h]); o.gb = bf2f(pr[C_GB + dir * 4 + h]);
    }
}
DEV void conv8_regs(const float* cw, const u32x4 (&x)[3], int chan, float (&o)[8]) {
    f32x4 w[3][2];
#pragma unroll
    for (int t3 = 0; t3 < 3; ++t3) { w[t3][0] = *(const f32x4*)(cw + t3 * 768 + chan); w[t3][1] = *(const f32x4*)(cw + t3 * 768 + chan + 4); }
#pragma unroll
    for (int j = 0; j < 8; ++j) {
        const float a = ((j & 1) ? bfhi(x[0][j >> 1]) : bflo(x[0][j >> 1])) * w[0][j >> 2][j & 3] + ((j & 1) ? bfhi(x[1][j >> 1]) : bflo(x[1][j >> 1])) * w[1][j >> 2][j & 3] +
                        ((j & 1) ? bfhi(x[2][j >> 1]) : bflo(x[2][j >> 1])) * w[2][j >> 2][j & 3];
        o[j] = a * __builtin_amdgcn_rcpf(1.0f + __expf(-a));
    }
}
DEV float shfl_lane(float v, int src) { return __int_as_float(__builtin_amdgcn_ds_bpermute(src << 2, __float_as_int(v))); }

DEV void gdn_prep_task(const DParams& p, int layer, int task, int next_task, GdnPre& pre, LAS unsigned char* lds, int tid, int wave_s) {
    const int n = task % 68, bh = task / 68, h = bh & 3;
    const int r = tid >> 3, c = tid & 7;
    LAS bf16_t* kk = (LAS bf16_t*)lds;
    LAS bf16_t* kT = kk + 64 * 72;
    LAS bf16_t* vv = kT + 64 * 72;
    constexpr int MS = 65, XS = 129;
    LAS float* M0 = (LAS float*)(vv + 64 * 72);
    LAS float* M1 = M0 + 64 * MS;
    LAS float* gs = M1 + 64 * MS;
    LAS float* xs = gs + 640;
    const float* cw = lp(p.gdn_conv_w) + (size_t)layer * 3 * 768;
    const int lane = tid & 63, lr = lane & 15, lq = lane >> 4;
    {
        float o[8];
        conv8_regs(cw, pre.kc, 256 + h * 64 + 8 * c, o);
        l2norm8(o, 1.0f);
        *(LAS u32x4*)(kk + r * 72 + 8 * c) = pack8(o);
#pragma unroll
        for (int j = 0; j < 8; ++j) kT[(8 * c + j) * 72 + (r ^ (8 * c))] = f2bf(o[j]);
        conv8_regs(cw, pre.vc, 512 + h * 64 + 8 * c, o);
        *(LAS u32x4*)(vv + r * 72 + 8 * c) = pack8(o);
        if (tid < 128) {
            const int dir = wave_s;
            const float arate = __expf(lp(p.gdn_a_log)[layer * 8 + dir * 4 + h]), dtb = lp(p.gdn_dt_bias)[layer * 8 + dir * 4 + h];
            const float g = -arate * softplusf(pre.ga + dtb), bt = sigmf(pre.gb);
            float v = shfl_lane(g, dir ? 63 - lane : lane);
            const int lid = lane_id();
#pragma unroll
            for (int off = 1; off < 64; off <<= 1) { const float t = shfl_lane(v, lid - off); if (lid >= off) v += t; }
            const float gc = shfl_lane(v, dir ? 63 - lane : lane);
            gs[128 + dir * 64 + lane] = bt; gs[256 + dir * 64 + lane] = gc;
            gs[384 + dir * 128 + lane] = bt; gs[384 + dir * 128 + 64 + lane] = bt * __expf(gc);
        }
    }
    if (next_task >= 0) gdn_pre_load(pre, p, next_task, tid);
    __syncthreads();
#pragma unroll
    for (int tt = 0; tt < 2; ++tt) {
        const int t = 2 * wave_s + tt, it = t >> 2, jt = t & 3;
        f32x4v acc = (f32x4v){0.f, 0.f, 0.f, 0.f};
#pragma unroll
        for (int ks = 0; ks < 2; ++ks)
            acc = MFMA16(*(const LAS bf16x8*)(kk + (16 * it + lr) * 72 + 32 * ks + 8 * lq), *(const LAS bf16x8*)(kk + (16 * jt + lr) * 72 + 32 * ks + 8 * lq), acc);
#pragma unroll
        for (int rg = 0; rg < 4; ++rg) {
            const int i = 16 * it + 4 * lq + rg, j = 16 * jt + lr;
            if (i > j) M0[j * MS + i] = -gs[128 + i] * acc[rg] * __expf(gs[256 + i] - gs[256 + j]);
            if (i < j) M1[(63 - j) * MS + (63 - i)] = -gs[192 + i] * acc[rg] * __expf(gs[320 + i] - gs[320 + j]);
        }
    }
    __syncthreads();
#define MFMA4F(a, b, c) __builtin_amdgcn_mfma_f32_16x16x4f32((a), (b), (c), 0, 0, 0)
    LAS float* DI = xs + 2 * 64 * XS;
    {
        const int d = wave_s >> 2, B = wave_s & 3;
        const LAS float* Mb = (d ? M1 : M0) + (16 * B) * MS + 16 * B;
        f32x4v PU, QU, EY;
        {
#pragma unroll
            for (int rg = 0; rg < 4; ++rg) {
                const int kx = 4 * lq + rg;
                const float pv = Mb[kx * MS + lr], qv = Mb[lr * MS + kx];
                QU[rg] = kx > lr ? qv : 0.f;
                PU[rg] = lr > kx ? pv : 0.f;
                EY[rg] = kx == lr ? 1.f : 0.f;
            }
        }
        const f32x4v Z4 = (f32x4v){0.f, 0.f, 0.f, 0.f};
        f32x4v PU2 = Z4, QU2 = Z4, PU4 = Z4, QU4 = Z4, QU8 = Z4, T1 = Z4, T2 = Z4, T3 = Z4;
#pragma unroll
        for (int rg = 0; rg < 4; ++rg) { PU2 = MFMA4F(QU[rg], PU[rg], PU2); QU2 = MFMA4F(PU[rg], QU[rg], QU2); }
#pragma unroll
        for (int rg = 0; rg < 4; ++rg) { PU4 = MFMA4F(QU2[rg], PU2[rg], PU4); QU4 = MFMA4F(PU2[rg], QU2[rg], QU4); T1 = MFMA4F(QU2[rg] + EY[rg], PU[rg] + EY[rg], T1); }
#pragma unroll
        for (int rg = 0; rg < 4; ++rg) { QU8 = MFMA4F(PU4[rg], QU4[rg], QU8); T2 = MFMA4F(QU4[rg] + EY[rg], T1[rg], T2); }
#pragma unroll
        for (int rg = 0; rg < 4; ++rg) T3 = MFMA4F(QU8[rg] + EY[rg], T2[rg], T3);
        *(LAS f32x4v*)(DI + wave_s * 256 + lr * 16 + 4 * lq) = T3;
    }
    __syncthreads();
    {
        f32x4v xr[2][4];
#pragma unroll
        for (int B = 0; B < 4; ++B) {
            f32x4v pa[2], pb[2], dv[2];
#pragma unroll
            for (int pp = 0; pp < 2; ++pp) {
                const int pr = 2 * wave_s + pp, d = pr >> 3, e = 16 * (pr & 7) + lr;
                const LAS bf16_t* src = e < 64 ? vv + e : kk + (e - 64);
                const LAS float* sc = gs + 384 + d * 128 + (e < 64 ? 0 : 64);
#pragma unroll
                for (int rg = 0; rg < 4; ++rg) { const int rho = 16 * B + 4 * lq + rg, i = d ? 63 - rho : rho; pa[pp][rg] = sc[i] * bf2f(src[i * 72]); pb[pp][rg] = 0.f; }
                dv[pp] = *(const LAS f32x4v*)(DI + (d * 4 + B) * 256 + lr * 16 + 4 * lq);
            }
#pragma unroll
            for (int Bp = 0; Bp < B; ++Bp) {
                float av[2][4];
#pragma unroll
                for (int pp = 0; pp < 2; ++pp) {
                    const LAS float* Mn = ((2 * wave_s + pp) >> 3) ? M1 : M0;
#pragma unroll
                    for (int rg = 0; rg < 4; ++rg) av[pp][rg] = Mn[(16 * Bp + 4 * lq + rg) * MS + 16 * B + lr];
                }
#pragma unroll
                for (int rg = 0; rg < 4; rg += 2)
#pragma unroll
                    for (int pp = 0; pp < 2; ++pp) {
                        pa[pp] = MFMA4F(av[pp][rg], xr[pp][Bp][rg], pa[pp]);
                        pb[pp] = MFMA4F(av[pp][rg + 1], xr[pp][Bp][rg + 1], pb[pp]);
                    }
            }
            f32x4v xa[2], xb[2];
#pragma unroll
            for (int pp = 0; pp < 2; ++pp) { pa[pp] = pa[pp] + pb[pp]; xa[pp] = (f32x4v){0.f, 0.f, 0.f, 0.f}; xb[pp] = xa[pp]; }
#pragma unroll
            for (int rg = 0; rg < 4; rg += 2)
#pragma unroll
                for (int pp = 0; pp < 2; ++pp) {
                    xa[pp] = MFMA4F(dv[pp][rg], pa[pp][rg], xa[pp]);
                    xb[pp] = MFMA4F(dv[pp][rg + 1], pa[pp][rg + 1], xb[pp]);
                }
#pragma unroll
            for (int pp = 0; pp < 2; ++pp) xr[pp][B] = xa[pp] + xb[pp];
        }
#pragma unroll
        for (int pp = 0; pp < 2; ++pp) {
            const int pr = 2 * wave_s + pp, d = pr >> 3, e = 16 * (pr & 7) + lr;
            LAS float* X = xs + d * (64 * XS) + e;
#pragma unroll
            for (int B = 0; B < 4; ++B)
#pragma unroll
                for (int rg = 0; rg < 4; ++rg) X[(16 * B + 4 * lq + rg) * XS] = xr[pp][B][rg];
        }
    }
#undef MFMA4F
    __syncthreads();
    {
#pragma unroll
        for (int d = 0; d < 2; ++d) {
            const size_t recd = ((size_t)bh * 2 + d) * 68 + n;
            const LAS float* X = xs + d * (64 * XS);
            float o[8];
            {
                const u32x4 kw = *(const LAS u32x4*)(kT + r * 72 + 8 * (c ^ (r >> 3)));
                const float gl = gs[256 + d * 64 + (d ? 0 : 63)];
#pragma unroll
                for (int j = 0; j < 8; ++j) o[j] = ((j & 1) ? bfhi(kw[j >> 1]) : bflo(kw[j >> 1])) * __expf(gl - gs[256 + d * 64 + 8 * c + j]);
                *(u32x4*)(GKT_(p) + recd * 4096 + r * 64 + 8 * c) = pack8(o);
            }
#pragma unroll
            for (int j = 0; j < 8; ++j) { const int i = 8 * c + j, rho = d ? 63 - i : i; o[j] = X[rho * XS + r]; }
            *(u32x4*)(GUT_(p) + recd * 4096 + r * 64 + 8 * c) = pack8(o);
            { const int rho = d ? 63 - r : r;
#pragma unroll
              for (int j = 0; j < 8; ++j) o[j] = -X[rho * XS + 64 + 8 * c + j]; }
            *(u32x4*)(GWN_(p) + recd * 4096 + r * 64 + 8 * c) = pack8(o);
        }
        if (tid < 128) GGC_(p)[(size_t)task * 128 + tid] = gs[256 + tid] * 1.44269504088896f;
    }
    __syncthreads();
}

struct GdnOps { bf16x8 aw[2], ak[2]; u32x2 uw[2]; float gl; };
DEV void gdn_ops_load(GdnOps& o, const bf16_t* gwn, const bf16_t* gkt, const bf16_t* gut, const float* ggc, int chain, int step, int it, int jt0, int lr, int lq) {
    const int dir = chain & 1, n = chain_chunk(dir, step);
    const size_t recd = (size_t)chain * 68 + n;
#pragma unroll
    for (int ks = 0; ks < 2; ++ks) {
        o.aw[ks] = *(const bf16x8*)(gwn + recd * 4096 + (16 * it + lr) * 64 + 32 * ks + 8 * lq);
        o.ak[ks] = *(const bf16x8*)(gkt + recd * 4096 + (16 * it + lr) * 64 + 32 * ks + 8 * lq);
    }
#pragma unroll
    for (int t = 0; t < 2; ++t) o.uw[t] = *(const u32x2*)(gut + recd * 4096 + (16 * (jt0 + t) + lr) * 64 + 16 * it + 4 * lq);
    o.gl = ggc[((size_t)(chain >> 1) * 68 + n) * 128 + dir * 64 + (dir == 0 ? 63 : 0)];
}
DEV void gdn_scan_chain(const DParams& p, int chain, LAS unsigned char* lds, int tid, int wave_s) {
    const int lane = tid & 63, lr = lane & 15, lq = lane >> 4, it = wave_s >> 1, jt0 = 2 * (wave_s & 1);
    const int dir = chain & 1;
    LAS bf16_t* ST = (LAS bf16_t*)lds;
    bf16_t* gwn = GWN_(p); const bf16_t* gkt = GKT_(p); bf16_t* gut = GUT_(p); const float* ggc = GGC_(p);
    f32x4v S[2];
#pragma unroll
    for (int t = 0; t < 2; ++t) S[t] = (f32x4v){0.f, 0.f, 0.f, 0.f};
    GdnOps o0, o1, o2, o3;
    gdn_ops_load(o0, gwn, gkt, gut, ggc, chain, 0, it, jt0, lr, lq); gdn_ops_load(o1, gwn, gkt, gut, ggc, chain, 1, it, jt0, lr, lq);
    gdn_ops_load(o2, gwn, gkt, gut, ggc, chain, 2, it, jt0, lr, lq); gdn_ops_load(o3, gwn, gkt, gut, ggc, chain, 3, it, jt0, lr, lq);
#define GDN_STEP(O, STEP) do { \
        const size_t recd = (size_t)chain * 68 + chain_chunk(dir, (STEP)); \
        LAS bf16_t* STb = ST + ((STEP) & 1) * (2 * 64 * 72); LAS bf16_t* VNb = STb + 64 * 72;     \
        f32x4v vn[2]; \
        _Pragma("unroll") for (int t = 0; t < 2; ++t) { \
            vn[t] = (f32x4v){bflo(O.uw[t].x), bfhi(O.uw[t].x), bflo(O.uw[t].y), bfhi(O.uw[t].y)}; \
            u32x2 sw; sw.x = pkbf(S[t][0], S[t][1]); sw.y = pkbf(S[t][2], S[t][3]); \
            *(LAS u32x2*)(STb + (16 * (jt0 + t) + lr) * 72 + 16 * it + 4 * lq) = sw; } \
        LDS_BARRIER(); \
        bf16x8 sf[2][2]; \
        _Pragma("unroll") for (int t = 0; t < 2; ++t) _Pragma("unroll") for (int ks = 0; ks < 2; ++ks) sf[t][ks] = *(const LAS bf16x8*)(STb + (16 * (jt0 + t) + lr) * 72 + 32 * ks + 8 * lq); \
        _Pragma("unroll") for (int ks = 0; ks < 2; ++ks) _Pragma("unroll") for (int t = 0; t < 2; ++t) vn[t] = MFMA16(O.aw[ks], sf[t][ks], vn[t]); \
        _Pragma("unroll") for (int t = 0; t < 2; ++t) { \
            u32x2 w; w.x = pkbf(vn[t][0], vn[t][1]); w.y = pkbf(vn[t][2], vn[t][3]); \
            *(LAS u32x2*)(VNb + (16 * (jt0 + t) + lr) * 72 + 16 * it + 4 * lq) = w; } \
        LDS_BARRIER(); \
        const float gt = ex2(O.gl); \
        bf16x8 vf[2][2]; \
        _Pragma("unroll") for (int t = 0; t < 2; ++t) _Pragma("unroll") for (int ks = 0; ks < 2; ++ks) vf[t][ks] = *(const LAS bf16x8*)(VNb + (16 * (jt0 + t) + lr) * 72 + 32 * ks + 8 * lq); \
          \
        { const u32x4 c0 = *(const LAS u32x4*)(STb + (tid >> 3) * 72 + 8 * (tid & 7)), c1 = *(const LAS u32x4*)(VNb + (tid >> 3) * 72 + 8 * (tid & 7)); \
            *(u32x4*)(gwn + recd * 4096 + tid * 8) = c0; *(u32x4*)(gut + recd * 4096 + tid * 8) = c1; } \
        _Pragma("unroll") for (int t = 0; t < 2; ++t) S[t] = S[t] * gt; \
        _Pragma("unroll") for (int ks = 0; ks < 2; ++ks) _Pragma("unroll") for (int t = 0; t < 2; ++t) S[t] = MFMA16(O.ak[ks], vf[t][ks], S[t]); \
        if ((STEP) + 4 < 68) gdn_ops_load(O, gwn, gkt, gut, ggc, chain, (STEP) + 4, it, jt0, lr, lq); \
    } while (0)
#pragma unroll
    for (int step = 0; step < 68; step += 4) { GDN_STEP(o0, step); GDN_STEP(o1, step + 1); GDN_STEP(o2, step + 2); GDN_STEP(o3, step + 3); }
#undef GDN_STEP
    __syncthreads();
}

template <bool GDN>
DEV void la_out_task(const DParams& p, int layer, int task, LAS unsigned char* lds, int gt, int gw) {
    const int n = task % 68, bh = task / 68, b = bh >> 2, h = bh & 3;
    const bool lat = n >= 4;
    const int row0 = chunk_row0(b, n);
    LAS bf16_t* q = (LAS bf16_t*)lds;
    LAS bf16_t* k = q + 64 * 72;
    LAS bf16_t* vT0 = k + 64 * 72;
    LAS bf16_t* vT1 = vT0 + 64 * 72;
    LAS bf16_t* ST0 = vT1 + 64 * 72;
    LAS bf16_t* ST1 = ST0 + 64 * 72;
    LAS bf16_t* A0 = ST1 + 64 * 72;
    LAS bf16_t* A1 = A0 + 64 * 72;
    LAS float* gcl = (LAS float*)(A1 + 64 * 72);
    const size_t s0 = ((size_t)bh * 2 + 0) * 68 + n, s1 = ((size_t)bh * 2 + 1) * 68 + n;
    const bf16_t* Pp = P_(p);
#pragma unroll
    for (int rep = 0; rep < 2; ++rep) {
        const int idx = gt + 256 * rep, r = idx >> 3, c = idx & 7;
        const bf16_t* prow = Pp + (size_t)(row0 + r) * PST;
        float o[8];
        if (GDN) {
            const float* cw = lp(p.gdn_conv_w) + (size_t)layer * 3 * 768;
            const int slen = n < 4 ? CTX : SQ, t0 = n < 4 ? n * 64 : (n - 4) * 64;
            const bool hasp = t0 + r > 0, hasn = t0 + r + 1 < slen;
            gdn_conv8(cw, prow + C_GQ + h * 64 + 8 * c, h * 64 + 8 * c, hasp, hasn, o);
            l2norm8(o, 0.125f);
            *(LAS u32x4*)(q + r * 72 + 8 * c) = pack8(o);
            gdn_conv8(cw, prow + C_GK + h * 64 + 8 * c, 256 + h * 64 + 8 * c, hasp, hasn, o);
            l2norm8(o, 1.0f);
            *(LAS u32x4*)(k + r * 72 + 8 * c) = pack8(o);
            *(LAS u32x4*)(vT0 + r * 72 + 8 * c) = *(const u32x4*)(GUT_(p) + s0 * 4096 + r * 64 + 8 * c);
            *(LAS u32x4*)(vT1 + r * 72 + 8 * c) = *(const u32x4*)(GUT_(p) + s1 * 4096 + r * 64 + 8 * c);
            *(LAS u32x4*)(ST0 + r * 72 + 8 * c) = *(const u32x4*)(GWN_(p) + s0 * 4096 + r * 64 + 8 * c);
            *(LAS u32x4*)(ST1 + r * 72 + 8 * c) = *(const u32x4*)(GWN_(p) + s1 * 4096 + r * 64 + 8 * c);
        } else {
            load_rope8(p, prow + C_RQ + h * 64, c, lat, (n - 4) * 64 + r, 1.0f, o);
            *(LAS u32x4*)(q + r * 72 + 8 * c) = pack8(o);
            load_rope8(p, prow + C_RK + h * 64, c, lat, (n - 4) * 64 + r, 0.125f, o);
            *(LAS u32x4*)(k + r * 72 + 8 * c) = pack8(o);
            const u32x4 vw = *(const u32x4*)(RVT_(p) + (size_t)task * 4096 + r * 64 + 8 * c);
            *(LAS u32x4*)(vT0 + r * 72 + 8 * c) = vw;
            *(LAS u32x4*)(vT1 + r * 72 + 8 * c) = vw;
            *(LAS u32x4*)(ST0 + r * 72 + 8 * c) = *(const u32x4*)(RST_(p) + s0 * 4096 + r * 64 + 8 * c);
            *(LAS u32x4*)(ST1 + r * 72 + 8 * c) = *(const u32x4*)(RST_(p) + s1 * 4096 + r * 64 + 8 * c);
        }
    }
    if (gt < 128) {
        if (GDN) gcl[gt] = GGC_(p)[(size_t)task * 128 + gt];
        else { const int d = gt >> 6, i = gt & 63; gcl[gt] = ret_lg2(p, layer, d, h) * (float)(d == 0 ? i + 1 : 64 - i); }
    }
    const int lane = gt & 63, lr = lane & 15, lq = lane >> 4;
    const int gcol = (GDN ? C_GZ : C_RG) + h * 64, mcol = (GDN ? 768 : 0) + h * 64;
    const int tokr = row0 + 16 * gw + lr;
    u32x2 gz[4];
#pragma unroll
    for (int t = 0; t < 4; ++t) gz[t] = *(const u32x2*)(Pp + (size_t)tokr * PST + gcol + 16 * t + 4 * lq);
    __syncthreads();
    {
        bf16x8 bq[2];
#pragma unroll
        for (int ks = 0; ks < 2; ++ks) bq[ks] = *(const LAS bf16x8*)(q + (16 * gw + lr) * 72 + 32 * ks + 8 * lq);
        const int i = 16 * gw + lr;
        const float gi0 = gcl[i], gi1 = gcl[64 + i];
#pragma unroll
        for (int jt = 0; jt < 4; ++jt) {
            f32x4v acc = (f32x4v){0.f, 0.f, 0.f, 0.f};
#pragma unroll
            for (int ks = 0; ks < 2; ++ks) acc = MFMA16(*(const LAS bf16x8*)(k + (16 * jt + lr) * 72 + 32 * ks + 8 * lq), bq[ks], acc);
            float f[4], g[4];
#pragma unroll
            for (int rg = 0; rg < 4; ++rg) {
                const int j = 16 * jt + 4 * lq + rg;
                f[rg] = i >= j ? acc[rg] * ex2(gi0 - gcl[j]) : 0.f;
                g[rg] = i <= j ? acc[rg] * ex2(gi1 - gcl[64 + j]) : 0.f;
            }
            u32x2 w0, w1; w0.x = pkbf(f[0], f[1]); w0.y = pkbf(f[2], f[3]); w1.x = pkbf(g[0], g[1]); w1.y = pkbf(g[2], g[3]);
            *(LAS u32x2*)(A0 + i * 72 + 16 * jt + 4 * lq) = w0;
            *(LAS u32x2*)(A1 + i * 72 + 16 * jt + 4 * lq) = w1;
        }
    }
    asm volatile("s_waitcnt lgkmcnt(0)" ::: "memory");
    f32x4v o[4];
#pragma unroll
    for (int t = 0; t < 4; ++t) o[t] = (f32x4v){0.f, 0.f, 0.f, 0.f};
#pragma unroll
    for (int d = 0; d < 2; ++d) {
        const LAS bf16_t* ST = d == 0 ? ST0 : ST1;
        const LAS bf16_t* AT = d == 0 ? A0 : A1;
        const LAS bf16_t* VT = d == 0 ? vT0 : vT1;
        bf16x8 bq[2], ba[2];
#pragma unroll
        for (int ks = 0; ks < 2; ++ks) {
            bq[ks] = *(const LAS bf16x8*)(q + (16 * gw + lr) * 72 + 32 * ks + 8 * lq);
            ba[ks] = *(const LAS bf16x8*)(AT + (16 * gw + lr) * 72 + 32 * ks + 8 * lq);
        }
        const float rsc = ex2(gcl[d * 64 + 16 * gw + lr]);
#pragma unroll
        for (int t = 0; t < 4; ++t) {
            f32x4v acc = (f32x4v){0.f, 0.f, 0.f, 0.f};
#pragma unroll
            for (int ks = 0; ks < 2; ++ks) acc = MFMA16(*(const LAS bf16x8*)(ST + (16 * t + lr) * 72 + 32 * ks + 8 * lq), bq[ks], acc);
            acc = acc * rsc;
#pragma unroll
            for (int ks = 0; ks < 2; ++ks) acc = MFMA16(*(const LAS bf16x8*)(VT + (16 * t + lr) * 72 + 32 * ks + 8 * lq), ba[ks], acc);
            o[t] = o[t] + acc;
        }
    }
    {
        const float* nw = GDN ? lp(p.gdn_norm_w) + (size_t)layer * 64 : lp(p.ret_norm_w) + (size_t)layer * 256 + h * 64;
        float ss = 0.f;
#pragma unroll
        for (int t = 0; t < 4; ++t) ss += (o[t][0] * o[t][0] + o[t][1] * o[t][1]) + (o[t][2] * o[t][2] + o[t][3] * o[t][3]);
        ss += shfl_xor_l(ss, 16); ss += shfl_xor_l(ss, 32);
        const float rs = __builtin_amdgcn_rsqf(ss * (1.0f / 64.0f) + 1e-6f);
        bf16_t* mp = H_(p) + (size_t)tokr * 1024 + mcol + 4 * lq;
#pragma unroll
        for (int t = 0; t < 4; ++t) {
            const f32x4v w4 = *(const f32x4v*)(nw + 16 * t + 4 * lq);
            const float g0 = bflo(gz[t].x), g1 = bfhi(gz[t].x), g2 = bflo(gz[t].y), g3 = bfhi(gz[t].y);
            u32x2 w; w.x = pkbf(o[t][0] * rs * w4[0] * siluf(g0), o[t][1] * rs * w4[1] * siluf(g1)); w.y = pkbf(o[t][2] * rs * w4[2] * siluf(g2), o[t][3] * rs * w4[3] * siluf(g3));
            *(u32x2*)(mp + 16 * t) = w;
        }
    }
    __syncthreads();
}


DEV void mix_prep_item(const DParams& p, int item2, LAS unsigned char* lds, int tid) {
    const int item = item2 >> 1, half = item2 & 1;
    const int b = item / 68, n = item % 68;
    const bool lat = n >= 4;
    const int row0 = chunk_row0(b, n), r = tid >> 3, c = tid & 7, t = (n - 4) * 64 + r;
    const bf16_t* prow = P_(p) + (size_t)(row0 + r) * PST;
    bf16_t* rktb = RKT_(p); bf16_t* rvtb = RVT_(p); bf16_t* ktb = KT_(p); bf16_t* vtb = VT_(p);
    u32x4 kx[3], kp[3], vx[3];
#pragma unroll
    for (int q = 0; q < 3; ++q) {
        const int kc = q < 2 ? C_RK + (2 * half + q) * 64 : C_SK + half * 64, vc = q < 2 ? C_RV + (2 * half + q) * 64 : C_SV + half * 64;
        kx[q] = *(const u32x4*)(prow + kc + 8 * c);
        kp[q] = lat ? *(const u32x4*)(prow + kc + 8 * (c ^ 2)) : kx[q];
        vx[q] = *(const u32x4*)(prow + vc + 8 * c);
    }
    f32x4 rt[4];
    {
        const int pos = lat ? ((c >> 2) == 0 ? t / 64 : t % 64) : 0;
        const float* rp = ROPE_(p) + (pos * 16 + 8 * (c & 1)) * 2;
#pragma unroll
        for (int q4 = 0; q4 < 4; ++q4) rt[q4] = *(const f32x4*)(rp + 4 * q4);
    }
    LAS bf16_t* tiles = (LAS bf16_t*)lds;
    const bool first = (c & 2) == 0;
    const int posk = kswz(r);
#pragma unroll
    for (int q = 0; q < 3; ++q) {
        float o[8];
#pragma unroll
        for (int j = 0; j < 8; ++j) {
            const float mine = (j & 1) ? bfhi(kx[q][j >> 1]) : bflo(kx[q][j >> 1]);
            if (lat) {
                const float oth = (j & 1) ? bfhi(kp[q][j >> 1]) : bflo(kp[q][j >> 1]);
                const float cs = rt[j >> 1][2 * (j & 1)], sn = rt[j >> 1][2 * (j & 1) + 1];
                o[j] = first ? mine * cs - oth * sn : oth * sn + mine * cs;
            } else o[j] = mine;
        }
        if (q < 2) {
            LAS bf16_t* kt = tiles + q * (64 * 72);
            LAS bf16_t* vt = tiles + (2 + q) * (64 * 72);
#pragma unroll
            for (int j = 0; j < 8; ++j) {
                kt[(8 * c + j) * 72 + (r ^ (8 * c))] = f2bf(o[j] * 0.125f);
                vt[(8 * c + j) * 72 + (r ^ (8 * c))] = (bf16_t)((vx[q][j >> 1] >> (16 * (j & 1))) & 0xffffu);
            }
        } else {
            const size_t rec = (size_t)(b * 2 + half) * 68 + n;
            *(u32x4*)(ktb + rec * 4096 + r * 64 + ((c ^ ((r >> 1) & 7)) * 8)) = pack8(o);
            LAS bf16_t* vt = tiles + 4 * (64 * 72);
#pragma unroll
            for (int j = 0; j < 8; ++j) vt[(8 * c + j) * 72 + (posk ^ (8 * c))] = (bf16_t)((vx[q][j >> 1] >> (16 * (j & 1))) & 0xffffu);
        }
    }
    __syncthreads();
#pragma unroll
    for (int q = 0; q < 2; ++q) {
        const size_t rec = (size_t)(b * 4 + 2 * half + q) * 68 + n;
        *(u32x4*)(rktb + rec * 4096 + r * 64 + 8 * c) = *(const LAS u32x4*)(tiles + q * (64 * 72) + r * 72 + 8 * (c ^ (r >> 3)));
        *(u32x4*)(rvtb + rec * 4096 + r * 64 + 8 * c) = *(const LAS u32x4*)(tiles + (2 + q) * (64 * 72) + r * 72 + 8 * (c ^ (r >> 3)));
    }
    {
        const size_t rec = (size_t)(b * 2 + half) * 68 + n;
        *(u32x4*)(vtb + rec * 4096 + r * 64 + ((c ^ ((r >> 1) & 7)) * 8)) = *(const LAS u32x4*)(tiles + 4 * (64 * 72) + r * 72 + 8 * (c ^ (r >> 3)));
    }
    __syncthreads();
}


DEV void ctx_res_tile(const DParams& p, int tile, const bf16_t* A, int lda, const bf16_t* Wt, int K, const float* xsrc, const float* modl, int gidx, const float* nwsc, bf16_t* An,
                      LAS unsigned char* lds, int tid, int wave_s) {
    const int rb = tile >> 3, cb = tile & 7, lane = tid & 63, lr = lane & 15, lq = lane >> 4, rt = wave_s & 3, ch = wave_s >> 2;
    const int nk = K / 64;
    const int ar = tid >> 3, ac = tid & 7;
    const bf16_t* ag = A + (size_t)(64 * rb + ar) * lda + 8 * ac;
    const bf16_t* bg0 = Wt + (size_t)(128 * cb + ar) * K + 8 * ac;
    const bf16_t* bg1 = bg0 + (size_t)64 * K;
    LAS bf16_t* buf = (LAS bf16_t*)lds;
    f32x4v acc[4];
#pragma unroll
    for (int j = 0; j < 4; ++j) acc[j] = (f32x4v){0.f, 0.f, 0.f, 0.f};
    u32x4 ra0, rb00, rb10, ra1 = (u32x4){0u, 0u, 0u, 0u}, rb01 = ra1, rb11 = ra1;
#define CT_LOAD(S, KT) do { ra##S = *(const u32x4*)(ag + 64 * (KT)); rb0##S = *(const u32x4*)(bg0 + 64 * (KT)); rb1##S = *(const u32x4*)(bg1 + 64 * (KT)); } while (0)
#define CT_STORE(S, BP) do { *(LAS u32x4*)((BP) + ar * 72 + 8 * ac) = ra##S; *(LAS u32x4*)((BP) + 64 * 72 + ar * 72 + 8 * ac) = rb0##S; *(LAS u32x4*)((BP) + 64 * 72 + (ar + 64) * 72 + 8 * ac) = rb1##S; } while (0)
#define CT_COMPUTE(CUR) do { bf16x8 af[2], bfr[4][2]; \
        _Pragma("unroll") for (int ks = 0; ks < 2; ++ks) { af[ks] = *(const LAS bf16x8*)((CUR) + (16 * rt + lr) * 72 + 32 * ks + 8 * lq); \
            _Pragma("unroll") for (int j = 0; j < 4; ++j) bfr[j][ks] = *(const LAS bf16x8*)((CUR) + 64 * 72 + (64 * ch + 16 * j + lr) * 72 + 32 * ks + 8 * lq); } \
        _Pragma("unroll") for (int ks = 0; ks < 2; ++ks) _Pragma("unroll") for (int j = 0; j < 4; ++j) acc[j] = MFMA16(af[ks], bfr[j][ks], acc[j]); } while (0)
    LAS bf16_t* buf0 = buf; LAS bf16_t* buf1 = buf + 192 * 72;
    CT_LOAD(0, 0);
    CT_STORE(0, buf0);
    if (nk > 1) CT_LOAD(1, 1);
    if (nk > 2) CT_LOAD(0, 2);
    LDS_BARRIER();
    for (int kt = 0; kt < nk; kt += 2) {
        if (kt + 1 < nk) CT_STORE(1, buf1);
        if (kt + 3 < nk) CT_LOAD(1, kt + 3);
        CT_COMPUTE(buf0);
        LDS_BARRIER();
        if (kt + 1 < nk) {
            if (kt + 2 < nk) CT_STORE(0, buf0);
            if (kt + 4 < nk) CT_LOAD(0, kt + 4);
            CT_COMPUTE(buf1);
            LDS_BARRIER();
        }
    }
#undef CT_LOAD
#undef CT_STORE
#undef CT_COMPUTE
    const int c0 = 128 * cb + 64 * ch + lr;
    float gv[4], nv[4];
#pragma unroll
    for (int j = 0; j < 4; ++j) { gv[j] = modl[(size_t)NB * NMOD * DM + gidx * DM + c0 + 16 * j]; nv[j] = nwsc[(size_t)NB * DM + c0 + 16 * j]; }
#pragma unroll
    for (int rg = 0; rg < 4; ++rg) {
        const int R = 64 * rb + 16 * rt + 4 * lq + rg;
        float xo[4];
#pragma unroll
        for (int j = 0; j < 4; ++j) xo[j] = xsrc[(size_t)R * DM + c0 + 16 * j];
        float sq = 0.f;
#pragma unroll
        for (int j = 0; j < 4; ++j) {
            const float xn = xo[j] + gv[j] * acc[j][rg];
            XC_(p)[(size_t)R * DM + c0 + 16 * j] = xn;
            An[(size_t)R * DM + c0 + 16 * j] = f2bf(xn * nv[j]);
            sq += xn * xn;
        }
        sq = row16_sum(sq);
        if (lr == 0) SSQ_(p)[(size_t)R * 16 + cb * 2 + ch] = sq;
    }
    __syncthreads();
}

DEV void gate_cols(const DParams& p, int layer, LAS unsigned char* lds, int tid, int wave_s) {
    const int lane = tid & 63, lr = lane & 15, lq = lane >> 4;
    LAS float* part = (LAS float*)lds;
    const bf16_t* Wt = WIN_(p) + (size_t)layer * NPAD * DM + (size_t)(C_GA + lr) * DM + 128 * wave_s + 8 * lq;
    for (int rgp = blockIdx.x; rgp < 256; rgp += gridDim.x) {
        const int R0 = rgp * (ROWS / 256);
        bf16x8 bfr[4], afr[9][4];
#pragma unroll
        for (int ks = 0; ks < 4; ++ks) bfr[ks] = *(const bf16x8*)(Wt + 32 * ks);
#pragma unroll
        for (int t = 0; t < 9; ++t) {
            const int rl = 16 * t + lr, rc = rl < ROWS / 256 ? rl : ROWS / 256 - 1;
            const bf16_t* ap = H_(p) + (size_t)(R0 + rc) * DM + 128 * wave_s + 8 * lq;
#pragma unroll
            for (int ks = 0; ks < 4; ++ks) afr[t][ks] = *(const bf16x8*)(ap + 32 * ks);
        }
        const int orow = tid >> 1, oc = 8 * (tid & 1), R = R0 + (orow < ROWS / 256 ? orow : 0);
        const f32x4* sp = (const f32x4*)(SSQ_(p) + (size_t)R * 16);
        const f32x4 s0 = sp[0], s1 = sp[1], s2 = sp[2], s3 = sp[3];
        const float* bp = BIAS_(p) + ((size_t)(layer * 2 + 0) * 9 + modrow(R)) * 5632 + C_GA + oc;
        const f32x4 b0 = *(const f32x4*)bp, b1 = *(const f32x4*)(bp + 4);
#pragma unroll
        for (int t = 0; t < 9; ++t) {
            f32x4v acc = (f32x4v){0.f, 0.f, 0.f, 0.f};
#pragma unroll
            for (int ks = 0; ks < 4; ++ks) acc = MFMA16(afr[t][ks], bfr[ks], acc);
#pragma unroll
            for (int rg = 0; rg < 4; ++rg) part[(wave_s * 9 + t) * 256 + (4 * lq + rg) * 16 + lr] = acc[rg];
        }
        __syncthreads();
        if (orow < ROWS / 256) {
            f32x4 a0 = (f32x4){0.f, 0.f, 0.f, 0.f}, a1 = a0;
#pragma unroll
            for (int w8 = 0; w8 < 8; ++w8) {
                const LAS f32x4* pp = (const LAS f32x4*)(part + (w8 * 9 + (orow >> 4)) * 256 + (orow & 15) * 16 + oc);
                a0 = a0 + pp[0]; a1 = a1 + pp[1];
            }
            const float ss = ((s0.x + s0.y) + (s0.z + s0.w)) + ((s1.x + s1.y) + (s1.z + s1.w)) + ((s2.x + s2.y) + (s2.z + s2.w)) + ((s3.x + s3.y) + (s3.z + s3.w));
            const float rs = __builtin_amdgcn_rsqf(ss * (1.0f / DM) + 1e-6f);
            a0 = a0 * rs + b0; a1 = a1 * rs + b1;
            u32x4 w; w.x = pg8::cvt_pk_bf16(a0.x, a0.y); w.y = pg8::cvt_pk_bf16(a0.z, a0.w); w.z = pg8::cvt_pk_bf16(a1.x, a1.y); w.w = pg8::cvt_pk_bf16(a1.z, a1.w);
            *(u32x4*)(P_(p) + (size_t)R * PST + C_GA + oc) = w;
        }
        __syncthreads();
    }
}

DEV void ph_m1(const DParams& p, int layer, LAS unsigned char* lds, int wave_s) {
    wave_s = launder_s(wave_s);
    const int tid = get_tid(wave_s);
    {
        GdnPre pre;
        int t = blockIdx.x;
        if (t < NB * 4 * 68) gdn_pre_load(pre, p, t, tid);
        for (; t < NB * 4 * 68; t += gridDim.x) {
            const int nt = t + (int)gridDim.x;
            gdn_prep_task(p, layer, t, nt < NB * 4 * 68 ? nt : -1, pre, lds, tid, wave_s);
        }
    }
    for (int t = (int)gridDim.x - 1 - (int)blockIdx.x; t < 2 * NB * 68; t += gridDim.x) mix_prep_item(p, t, lds, tid);
}
DEV void ph_m2(const DParams& p, int layer, bool need_ctx, LAS unsigned char* lds, int wave_s) {
    wave_s = launder_s(wave_s);
    const int tid = get_tid(wave_s);
    const int rb = (int)gridDim.x - 1 - (int)blockIdx.x;
    for (int ch = rb; ch < NB * 4 * 2; ch += gridDim.x) gdn_scan_chain(p, ch, lds, tid, wave_s);
    for (int ch = rb - NB * 4 * 2; ch < NB * 4 * 2; ch += gridDim.x) if (ch >= 0) ret_scan_chain(p, layer, ch, tid, wave_s);
    const int nunits = NB * 2 * 64 + (need_ctx ? NB * 2 * 4 : 0);
    unsigned* ctr = (unsigned*)(lp(p.ws) + O_CTR) + layer * 16;
    volatile LAS unsigned* slot = (volatile LAS unsigned*)(lds + LDS_BYTES - 32);
    for (;;) {
        if (tid == 0) slot[0] = atomicAdd(ctr, 1u);
        __syncthreads();
        const int u = (int)slot[0];
        __syncthreads();
        if (u >= nunits) break;
        swa_unit(p, layer, u, lds, tid, wave_s);
    }
}
DEV void ph_m3(const DParams& p, int layer, bool need_ctx, LAS unsigned char* lds, int wave_s) {
    wave_s = launder_s(wave_s);
    const int tid = get_tid(wave_s), gt = tid & 255, gw = wave_s & 3;
    const int nch = need_ctx ? 68 : 64, ntask = NB * 4 * nch;
    for (int t = blockIdx.x; t < ntask; t += gridDim.x) {
        const int tk = (t / nch) * 68 + (68 - nch) + (t % nch);
        const int gwl = launder_s(gw);
        if (wave_s < 4) la_out_task<false>(p, layer, tk, lds, gt, gwl);
        else la_out_task<true>(p, layer, tk, lds + 74240, gt, gwl);
    }
}
DEV void ph_final(const DParams& p, int wave_s) {
    wave_s = launder_s(wave_s);
    const int tid_ = get_tid(wave_s), lane = tid_ & 63, gw = blockIdx.x * NW + (tid_ >> 6), ngw = gridDim.x * NW;
    for (int r = gw; r < NB * SQ; r += ngw) {
        f32x4* xr = (f32x4*)(lp(p.XL) + (size_t)r * DM) + lane;
        f32x4 v[4]; float s = 0.f;
#pragma unroll
        for (int j = 0; j < 4; ++j) { v[j] = xr[64 * j]; s += (v[j].x * v[j].x + v[j].y * v[j].y) + (v[j].z * v[j].z + v[j].w * v[j].w); }
        const float rs = 1.0f / sqrtf(wave_sum(s) * (1.0f / DM) + 1e-6f);
        const f32x4* w4 = (const f32x4*)lp(p.final_norm_w) + lane;
#pragma unroll
        for (int j = 0; j < 4; ++j) xr[64 * j] = v[j] * rs * w4[64 * j];
    }
}

__global__ void __launch_bounds__(NT, 2) mega(Params kargs) {
    extern __shared__ __attribute__((aligned(16))) unsigned char lds_raw[];
    LAS unsigned char* lds = (LAS unsigned char*)lds_raw;
    const int wave_s = __builtin_amdgcn_readfirstlane(threadIdx.x >> 6);
    volatile LAS unsigned* bst = (volatile LAS unsigned*)(lds + LDS_BYTES - 16);
    if (threadIdx.x == 0) { bst[0] = 0u; bst[1] = 0u; }
    __syncthreads();
    const XcdBarrier bar = xcd_barrier_post((unsigned*)(kargs.ws + O_BAR), bst, (int)threadIdx.x);
    cg::this_grid().sync();
#define GSYNC() xcd_barrier(bar, get_tid(wave_s))
    const int G = gridDim.x, bid = blockIdx.x;
    { const DParams p = load_params(); ph_prologue(p, lds, wave_s); }
    GSYNC();
    { const DParams p = load_params(); ph_pre0(p, lds, wave_s); }
    GSYNC();
    for (int layer = 0; layer < 2; ++layer) {
        const bool need_ctx = layer == 0;
        const int rlo = need_ctx ? 0 : NCR, M2 = ROWS - rlo;
        {
            const DParams p = load_params();
            pg8::Gemm g{H_(p), WIN_(p) + (size_t)layer * NPAD * DM, ROWS, C_GA, DM}; pg8::StaticOrder S; S.init(ROWS, C_GA, G, bid);
            EpiP E{P_(p), PST, SSQ_(p), BIAS_(p) + (size_t)(layer * 2 + 0) * 9 * 5632};
            pg8::gemm_phase<EpiP, pg8::StaticOrder, false>(lds, g, S, E, nullptr, wave_s);
            { const int wl = launder_s(wave_s); gate_cols(p, layer, lds, get_tid(wl), wl); }
        }
        GSYNC();
        { const DParams p = load_params(); ph_m1(p, layer, lds, wave_s); }
        GSYNC();
        { const DParams p = load_params(); ph_m2(p, layer, need_ctx, lds, wave_s); }
        GSYNC();
        { const DParams p = load_params(); ph_m3(p, layer, need_ctx, lds, wave_s); }
        GSYNC();
        {
            const DParams p = load_params(); const float* modl = MOD_(p) + (size_t)layer * (NB + 1) * NMOD * DM;
            pg8::Gemm g{H_(p) + (size_t)NCR * 1024, WOUT_(p) + (size_t)layer * DM * 1024, ROWS - NCR, DM, 1024}; pg8::StaticOrder S; S.init(ROWS - NCR, DM, G, bid);
            EpiRes E{layer == 0 ? lp(p.x) : (const float*)lp(p.XL), XC_(p), lp(p.XL), XC_(p), modl, 2, NCR,
                     NWSC_(p) + (size_t)(layer * 2 + 1) * 9 * DM, A2_(p), SSQ_(p)};
            pg8::gemm_phase<EpiRes, pg8::StaticOrder, false>(lds, g, S, E, nullptr, wave_s);
            if (layer == 0) { const int wl = launder_s(wave_s), tid = get_tid(wl);
                for (int t = bid; t < 256; t += G) ctx_res_tile(p, t, H_(p), 1024, WOUT_(p), 1024, lp(p.ctx), modl, 2, NWSC_(p) + (size_t)(0 * 2 + 1) * 9 * DM, A2_(p), lds, tid, wl); }
        }
        GSYNC();
        {
            const DParams p = load_params();
            pg8::Gemm g{A2_(p) + (size_t)rlo * 1024, WF1_(p) + (size_t)layer * 2 * DFF * DM, M2, 2 * DFF, DM}; pg8::StaticOrder S; S.init(M2, 2 * DFF, G, bid);
            EpiSwiglu E{P_(p) + (size_t)rlo * DFF, DFF, SSQ_(p), BIAS_(p) + (size_t)(layer * 2 + 1) * 9 * 5632, rlo};
            pg8::gemm_phase<EpiSwiglu, pg8::StaticOrder, false>(lds, g, S, E, nullptr, wave_s);
        }
        GSYNC();
        {
            const DParams p = load_params(); const float* modl = MOD_(p) + (size_t)layer * (NB + 1) * NMOD * DM;
            pg8::Gemm g{P_(p) + (size_t)NCR * DFF, WF2_(p) + (size_t)layer * DM * DFF, ROWS - NCR, DM, DFF}; pg8::StaticOrder S; S.init(ROWS - NCR, DM, G, bid);
            EpiRes E{lp(p.XL), XC_(p), lp(p.XL), XC_(p), modl, 5, NCR, layer == 0 ? NWSC_(p) + (size_t)(1 * 2 + 0) * 9 * DM : (const float*)nullptr, H_(p), SSQ_(p)};
            pg8::gemm_phase<EpiRes, pg8::StaticOrder, false>(lds, g, S, E, nullptr, wave_s);
            if (layer == 0) { const int wl = launder_s(wave_s), tid = get_tid(wl);
                for (int t = bid; t < 256; t += G) ctx_res_tile(p, t, P_(p), DFF, WF2_(p), DFF, XC_(p), modl, 5, NWSC_(p) + (size_t)(1 * 2 + 0) * 9 * DM, H_(p), lds, tid, wl); }
        }
        GSYNC();
    }
    { const DParams p = load_params(); ph_final(p, wave_s); }
}

extern "C" void kernel_launch(void* const* d_in, const int* in_sizes, int n_in, void* d_out, int out_size, void* d_ws, size_t ws_size,
                              hipStream_t stream) {
    static int grid_blocks = 0;
    if (!grid_blocks) {
        int dev = 0, cus = 0, per_cu = 0;
        (void)hipGetDevice(&dev);
        (void)hipDeviceGetAttribute(&cus, hipDeviceAttributeMultiprocessorCount, dev);
        (void)hipFuncSetAttribute((const void*)mega, hipFuncAttributeMaxDynamicSharedMemorySize, LDS_BYTES);
        (void)hipOccupancyMaxActiveBlocksPerMultiprocessor(&per_cu, (const void*)mega, NT, LDS_BYTES);
        if (per_cu < 1) { fprintf(stderr, "occupancy query says %d blocks/CU\n", per_cu); per_cu = 1; }
        grid_blocks = cus;
    }
    Params p{};
    const float** ip = (const float**)&p;
    for (int i = 0; i < 20; ++i) ip[i] = (const float*)d_in[i];
    p.XL = (float*)d_out;
    p.ws = (char*)d_ws;
    if (WS_END > ws_size) { fprintf(stderr, "ws too small: need %zu have %zu\n", (size_t)WS_END, ws_size); return; }
    (void)hipMemsetAsync((char*)d_ws + O_BAR, 0, BAR_BYTES, stream);
    void* args[] = {&p};
    hipError_t e = hipLaunchCooperativeKernel((void*)mega, dim3(grid_blocks), dim3(NT), args, LDS_BYTES, stream);
    if (e != hipSuccess) fprintf(stderr, "cooperative launch failed: %s (grid %d)\n", hipGetErrorString(e), grid_blocks);
}
```

```cpp
#include <hip/hip_runtime.h>
#include <hip/hip_cooperative_groups.h>
#include <cstdio>
#include <cstdint>
namespace cg = cooperative_groups;
__device__ __forceinline__ int lane_id();
__device__ __forceinline__ int launder_s(int v);
namespace pg8 {
#define PG8_LAS __attribute__((address_space(3)))
typedef unsigned short bf16_t;
typedef short bf16x8 __attribute__((ext_vector_type(8)));
typedef float f32x4 __attribute__((ext_vector_type(4)));
typedef unsigned u32x4 __attribute__((ext_vector_type(4)));
constexpr int BM = 256, BK = 64, HALF = 128, HTB = HALF * BK * 2  , STAGE_BYTES = 8 * HTB, NXCD = 8, WGM = 8;

__host__ __device__ __forceinline__ int lds_byte(int r, int c) { const int st = (r >> 4) * 2 + (c >> 5), rr = r & 15, cc = c & 31, ob = rr * 64 + cc * 2; return st * 1024 + (ob ^ (((ob >> 9) & 1) << 5)); }
__host__ __device__ __forceinline__ void stage_rc(int b, int& R, int& C) { const int st = b / 1024, sb = b % 1024, swz = sb ^ (((sb >> 9) & 1) << 5); R = (st >> 1) * 16 + swz / 64; C = (st & 1) * 32 + (swz % 64) / 2; }
__host__ __device__ __forceinline__ int perm32(int rho) { const int n = rho >> 4, i = rho & 15; return 8 * (i >> 2) + 4 * n + (i & 3); }
struct Unit { int pm, pn; };
struct Gemm { const bf16_t* A; const bf16_t* Bt; int M, N, K; };
struct StaticOrder {
    int nM, nN, nwg, G, c;
    __host__ __device__ void init(int M, int N, int G_, int c_) { nM = M / BM; nN = N / BM; nwg = nM * nN; G = G_; c = c_; }
    __host__ __device__ bool next(int i, Unit& u) const {
        const long L = (long)i * G + c; if (L >= nwg) return false;
        int wgid = (int)L; { const int q = nwg / NXCD, r = nwg % NXCD, xcd = wgid % NXCD, off = wgid / NXCD; wgid = (xcd < r ? xcd * (q + 1) : r * (q + 1) + (xcd - r) * q) + off; }
        const int nig = WGM * nN, gid = wgid / nig, fm = gid * WGM, gsz = (nM - fm) < WGM ? (nM - fm) : WGM;
        u.pm = fm + ((wgid % nig) % gsz); u.pn = (wgid % nig) / gsz; return true;
    }
    __device__ __forceinline__ void a_ready(const Unit&) const {}
    __device__ __forceinline__ void done(const Unit&) const {}
};
__device__ __forceinline__ unsigned cvt_pk_bf16(float lo, float hi) { unsigned r; asm volatile("v_cvt_pk_bf16_f32 %0, %1, %2" : "=v"(r) : "v"(lo), "v"(hi)); return r; }
template <class Epi, class Sched, bool STAMP = false>
__device__ __forceinline__ void gemm_phase(PG8_LAS unsigned char* lds, const Gemm g, const Sched& S, const Epi& E, unsigned long long* stamps, int wave_s) {
    const int wid = launder_s(wave_s), tid = wid * 64 + lane_id(), lane = tid & 63, wr = wid >> 2, wc = wid & 3, fr = lane & 15, fq = lane >> 4;
    const int K = g.K, nt = K / BK;
    int ts_lo = 0, ts_hi = 0, nts = 0; const unsigned long long rt_entry = STAMP ? (unsigned long long)wall_clock64() : 0ull;
#define PG8_STAMP() do { if (STAMP && wid == 0 && nts < 64) { const unsigned long long _c = (unsigned long long)clock64(); \
        ts_lo = (lane == nts) ? (int)(unsigned)_c : ts_lo; ts_hi = (lane == nts) ? (int)(unsigned)(_c >> 32) : ts_hi; ++nts; } } while (0)
    PG8_STAMP();
    unsigned voffA[2], voffB[2];
#pragma unroll
    for (int i = 0; i < 2; ++i) { int R, C; stage_rc(tid * 16 + i * 8192, R, C); const int Rb = Epi::PERM ? ((R & ~31) + perm32(R & 31)) : R;
        voffA[i] = (unsigned)(R * K + C) * 2u; voffB[i] = (unsigned)(Rb * K + C) * 2u; }
    const size_t kstep = (size_t)(BK * 2);
    const size_t hstep = (size_t)HALF * K * 2;
    const size_t tstep = 2 * hstep;
    const unsigned ldsw = (unsigned)wid * 1024u;
    const int aoff = lds_byte(wr * 64 + fr, fq * 8), boff = lds_byte(wc * 32 + fr, fq * 8);
#define PG8_SA(b, h) (((b) * 2 + (h)) * HTB)
#define PG8_SB(b, h) ((4 + (b) * 2 + (h)) * HTB)
#define PG8_STAGE(bufoff, gbase, voff) do { _Pragma("unroll") for (int _i = 0; _i < 2; ++_i) \
        __builtin_amdgcn_global_load_lds((const unsigned*)((const char*)(gbase) + (voff)[_i]), (PG8_LAS unsigned*)(lds + (bufoff) + ldsw + _i * 8192), 16, 0, 0); } while (0)
#define PG8_LDA(dst, b, h) do { _Pragma("unroll") for (int m = 0; m < 4; ++m) _Pragma("unroll") for (int k = 0; k < 2; ++k) dst[m][k] = *(const PG8_LAS bf16x8*)(lds + PG8_SA(b, h) + aoff + m * 2048 + k * 1024); } while (0)
#define PG8_LDB(dst, b, h) do { _Pragma("unroll") for (int n = 0; n < 2; ++n) _Pragma("unroll") for (int k = 0; k < 2; ++k) dst[n][k] = *(const PG8_LAS bf16x8*)(lds + PG8_SB(b, h) + boff + n * 2048 + k * 1024); } while (0)
#define PG8_MMA(ai, bj, At, Bt) do { __builtin_amdgcn_s_setprio(1); _Pragma("unroll") for (int m = 0; m < 4; ++m) _Pragma("unroll") for (int n = 0; n < 2; ++n) _Pragma("unroll") for (int k = 0; k < 2; ++k) \
        acc[ai][bj][m][n] = __builtin_amdgcn_mfma_f32_16x16x32_bf16(Bt[n][k], At[m][k], acc[ai][bj][m][n], 0, 0, 0); __builtin_amdgcn_s_setprio(0); } while (0)
#define PG8_WAIT_V(n) asm volatile("s_waitcnt vmcnt(" #n ")" ::: "memory")
#define PG8_WAIT_L(n) asm volatile("s_waitcnt lgkmcnt(" #n ")" ::: "memory")
#define PG8_BAR __builtin_amdgcn_s_barrier()
#define PG8_SCHED __builtin_amdgcn_sched_barrier(0)
    Unit cur, nxt; int ui = 0;
    if (!S.next(0, cur)) return;
    f32x4 acc[2][2][4][2];
#pragma unroll
    for (int a = 0; a < 2; ++a)
#pragma unroll
        for (int b = 0; b < 2; ++b)
#pragma unroll
            for (int m = 0; m < 4; ++m)
#pragma unroll
                for (int n = 0; n < 2; ++n) acc[a][b][m][n] = (f32x4){0.f, 0.f, 0.f, 0.f};
    bf16x8 At[4][2], B0[2][2], B1[2][2];
    const char* cA = (const char*)g.A + (size_t)cur.pm * tstep; const char* cB = (const char*)g.Bt + (size_t)cur.pn * tstep;
    S.a_ready(cur);
    PG8_STAGE(PG8_SB(0, 0), cB, voffB); PG8_STAGE(PG8_SA(0, 0), cA, voffA); PG8_STAGE(PG8_SB(0, 1), cB + hstep, voffB); PG8_STAGE(PG8_SA(0, 1), cA + hstep, voffA);
    if (wr == 1) PG8_BAR;
    PG8_WAIT_V(4); PG8_BAR;
    PG8_STAGE(PG8_SB(1, 0), cB + kstep, voffB); PG8_STAGE(PG8_SA(1, 0), cA + kstep, voffA); PG8_STAGE(PG8_SB(1, 1), cB + hstep + kstep, voffB);
    PG8_WAIT_V(6); PG8_BAR;
    PG8_STAMP();
    for (;;) {
        const bool has_next = S.next(ui + 1, nxt);
        const char* nA = has_next ? (const char*)g.A + (size_t)nxt.pm * tstep : cA; const char* nB = has_next ? (const char*)g.Bt + (size_t)nxt.pn * tstep : cB;
        for (int t = 0; t < nt; t += 2) {
            const bool last = (t == nt - 2);
            const char* a1 = cA + (size_t)(t + 1) * kstep;
            const char* a2 = last ? nA : cA + (size_t)(t + 2) * kstep; const char* b2 = last ? nB : cB + (size_t)(t + 2) * kstep;
            const char* a3 = a2 + kstep; const char* b3 = b2 + kstep;
            if (last && has_next) S.a_ready(nxt);
            PG8_LDB(B0, 0, 0); PG8_SCHED; PG8_LDA(At, 0, 0); PG8_STAGE(PG8_SA(1, 1), a1 + hstep, voffA);
            PG8_WAIT_L(8); PG8_BAR; PG8_WAIT_L(0); PG8_MMA(0, 0, At, B0); PG8_BAR; PG8_SCHED;
            PG8_LDB(B1, 0, 1); PG8_STAGE(PG8_SB(0, 0), b2, voffB);
            PG8_BAR; PG8_WAIT_L(0); PG8_MMA(0, 1, At, B1); PG8_BAR;
            PG8_LDA(At, 0, 1); PG8_STAGE(PG8_SA(0, 0), a2, voffA);
            PG8_BAR; PG8_WAIT_L(0); PG8_MMA(1, 0, At, B0); PG8_BAR; PG8_SCHED;
            PG8_STAGE(PG8_SB(0, 1), b2 + hstep, voffB);
            PG8_WAIT_V(6); PG8_BAR; PG8_MMA(1, 1, At, B1); PG8_BAR;
            PG8_LDB(B0, 1, 0); PG8_SCHED; PG8_LDA(At, 1, 0); PG8_STAGE(PG8_SA(0, 1), a2 + hstep, voffA);
            PG8_WAIT_L(8); PG8_BAR; PG8_WAIT_L(0); PG8_MMA(0, 0, At, B0); PG8_BAR; PG8_SCHED;
            PG8_LDB(B1, 1, 1); PG8_STAGE(PG8_SB(1, 0), b3, voffB);
            PG8_BAR; PG8_WAIT_L(0); PG8_MMA(0, 1, At, B1); PG8_BAR;
            PG8_LDA(At, 1, 1); PG8_STAGE(PG8_SA(1, 0), a3, voffA);
            PG8_BAR; PG8_WAIT_L(0); PG8_MMA(1, 0, At, B0); PG8_BAR; PG8_SCHED;
            PG8_STAGE(PG8_SB(1, 1), b3 + hstep, voffB);
            PG8_WAIT_V(6); PG8_BAR; PG8_MMA(1, 1, At, B1); PG8_BAR;
        }
        PG8_STAMP();
        if constexpr (!Epi::AFTER_DRAIN) { E(acc, cur, wr, wc, fr, fq); S.done(cur); }
        PG8_STAMP();
        if (!has_next) break;
#pragma unroll
        for (int a = 0; a < 2; ++a)
#pragma unroll
            for (int b = 0; b < 2; ++b)
#pragma unroll
                for (int m = 0; m < 4; ++m)
#pragma unroll
                    for (int n = 0; n < 2; ++n) acc[a][b][m][n] = (f32x4){0.f, 0.f, 0.f, 0.f};
        cur = nxt; cA = nA; cB = nB; ++ui;
    }
    PG8_WAIT_V(0);
    if (wr == 0) PG8_BAR;
    PG8_BAR;
    if constexpr (Epi::AFTER_DRAIN) { E.fused(acc, cur, wr, wc, fr, fq, lds, wid, lane); S.done(cur); }
    PG8_STAMP();
    if (STAMP && wid == 0) { stamps[lane] = lane < nts ? (((unsigned long long)(unsigned)ts_hi << 32) | (unsigned)ts_lo) : 0ull;
        if (lane == 62) stamps[62] = rt_entry; if (lane == 63) stamps[63] = (unsigned long long)wall_clock64(); }
#undef PG8_STAMP
#undef PG8_SA
#undef PG8_SB
#undef PG8_STAGE
#undef PG8_LDA
#undef PG8_LDB
#undef PG8_MMA
#undef PG8_WAIT_V
#undef PG8_WAIT_L
#undef PG8_BAR
#undef PG8_SCHED
}
}

using pg8::bf16_t; using pg8::f32x4; using pg8::u32x4; using pg8::Unit;
#define LAS __attribute__((address_space(3)))
typedef unsigned u32x2 __attribute__((ext_vector_type(2)));
#define DEV __device__ __forceinline__

constexpr int NT = 512, NW = 8;
constexpr int DM = 1024, NB = 8, SQ = 4096, CTX = 256;
constexpr int NCR = NB * CTX;
constexpr int ROWS = NCR + NB * SQ;
constexpr int DFF = 2816, INW = 2832, PST = 2832, NPAD = 3072, NMOD = 6;
constexpr int C_RQ = 0, C_RK = 256, C_RV = 512, C_RG = 768, C_SQ = 1024, C_SK = 1536, C_SV = 1664,
              C_GQ = 1792, C_GK = 2048, C_GV = 2304, C_GZ = 2560, C_GA = 2816, C_GB = 2824;
constexpr int LDS_BYTES = 146 * 1024;

struct Params {
    const float *x, *c, *ctx, *c_ctx, *ada_w, *ada_b, *norm_mix_w, *norm_ffn_w, *w_in, *ret_rate, *ret_norm_w,
        *swa_sinks, *gdn_conv_w, *gdn_a_log, *gdn_dt_bias, *gdn_norm_w, *w_out, *w_ffn_in, *w_ffn_out, *final_norm_w;
    float* XL;
    char* ws;
};

constexpr size_t al256(size_t x) { return (x + 255) & ~(size_t)255; }
constexpr size_t O_XC = 0;
constexpr size_t O_MOD = O_XC + al256((size_t)NCR * DM * 4);
constexpr size_t O_ROPE = O_MOD + al256((size_t)2 * (NB + 1) * NMOD * DM * 4);
constexpr size_t O_WIN = O_ROPE + al256(64 * 16 * 2 * 4 + 64);
constexpr size_t O_WOUT = O_WIN + al256((size_t)2 * NPAD * DM * 2);
constexpr size_t O_WF1 = O_WOUT + al256((size_t)2 * DM * 1024 * 2);
constexpr size_t O_WF2 = O_WF1 + al256((size_t)2 * 2 * DFF * DM * 2);
constexpr size_t O_H = O_WF2 + al256((size_t)2 * DM * DFF * 2);
constexpr size_t O_P = O_H + al256((size_t)ROWS * 1024 * 2);
constexpr size_t O_OG = O_P + al256((size_t)ROWS * PST * 2);
constexpr size_t O_KT = O_OG;
constexpr size_t O_VT = O_KT + al256((size_t)NB * 2 * 68 * 4096 * 2);
constexpr size_t O_RKT = O_VT + al256((size_t)NB * 2 * 68 * 4096 * 2);
constexpr size_t O_RVT = O_RKT + al256((size_t)NB * 4 * 68 * 4096 * 2);
constexpr size_t O_RST = O_RVT + al256((size_t)NB * 4 * 68 * 4096 * 2);
constexpr size_t O_GKT = O_RST + al256((size_t)NB * 4 * 2 * 68 * 4096 * 2);
constexpr size_t O_GUT = O_GKT + al256((size_t)NB * 4 * 2 * 68 * 4096 * 2);
constexpr size_t O_GWN = O_GUT + al256((size_t)NB * 4 * 2 * 68 * 4096 * 2);
constexpr size_t O_GGC = O_GWN + al256((size_t)NB * 4 * 2 * 68 * 4096 * 2);
constexpr size_t O_NWSC = O_GGC + al256((size_t)NB * 4 * 68 * 128 * 4);
constexpr size_t O_BIAS = O_NWSC + al256((size_t)2 * 2 * 9 * 1024 * 4);
constexpr size_t O_SSQ = O_BIAS + al256((size_t)2 * 2 * 9 * 5632 * 4);
constexpr size_t O_BAR = O_SSQ + al256((size_t)ROWS * 16 * 4);
constexpr size_t BAR_BYTES = 3456 * 4 + 256;
constexpr size_t O_CTR = O_BAR + 3456 * 4;
constexpr size_t WS_END = O_BAR + al256(BAR_BYTES);
#define GAS __attribute__((address_space(1)))
#define CAS __attribute__((address_space(4)))
struct DParams {
    GAS const float *x, *c, *ctx, *c_ctx, *ada_w, *ada_b, *norm_mix_w, *norm_ffn_w, *w_in, *ret_rate, *ret_norm_w,
        *swa_sinks, *gdn_conv_w, *gdn_a_log, *gdn_dt_bias, *gdn_norm_w, *w_out, *w_ffn_in, *w_ffn_out, *final_norm_w;
    GAS float* XL;
    GAS char* ws;
};
DEV DParams load_params() {
    const CAS unsigned long long* kp = (const CAS unsigned long long*)__builtin_amdgcn_kernarg_segment_ptr();
    asm volatile("" : "+s"(kp));
    DParams r;
    r.x = (GAS const float*)kp[0]; r.c = (GAS const float*)kp[1]; r.ctx = (GAS const float*)kp[2]; r.c_ctx = (GAS const float*)kp[3];
    r.ada_w = (GAS const float*)kp[4]; r.ada_b = (GAS const float*)kp[5]; r.norm_mix_w = (GAS const float*)kp[6]; r.norm_ffn_w = (GAS const float*)kp[7];
    r.w_in = (GAS const float*)kp[8]; r.ret_rate = (GAS const float*)kp[9]; r.ret_norm_w = (GAS const float*)kp[10]; r.swa_sinks = (GAS const float*)kp[11];
    r.gdn_conv_w = (GAS const float*)kp[12]; r.gdn_a_log = (GAS const float*)kp[13]; r.gdn_dt_bias = (GAS const float*)kp[14]; r.gdn_norm_w = (GAS const float*)kp[15];
    r.w_out = (GAS const float*)kp[16]; r.w_ffn_in = (GAS const float*)kp[17]; r.w_ffn_out = (GAS const float*)kp[18]; r.final_norm_w = (GAS const float*)kp[19];
    r.XL = (GAS float*)kp[20]; r.ws = (GAS char*)kp[21];
    return r;
}
template <class T> DEV T* lp(GAS T* q) { return (T*)q; }
#define WSP(T, name, OFF) DEV T* name(const DParams& p) { return (T*)(lp(p.ws) + (OFF)); }
WSP(float, XC_, O_XC) WSP(float, MOD_, O_MOD) WSP(float, ROPE_, O_ROPE) WSP(bf16_t, WIN_, O_WIN) WSP(bf16_t, WOUT_, O_WOUT) WSP(bf16_t, WF1_, O_WF1)
WSP(bf16_t, WF2_, O_WF2) WSP(bf16_t, H_, O_H) WSP(bf16_t, P_, O_P)  WSP(bf16_t, KT_, O_KT) WSP(bf16_t, VT_, O_VT) WSP(bf16_t, RKT_, O_RKT) WSP(bf16_t, RVT_, O_RVT) WSP(bf16_t, RST_, O_RST) WSP(bf16_t, GKT_, O_GKT) WSP(bf16_t, GUT_, O_GUT) WSP(bf16_t, GWN_, O_GWN) WSP(float, GGC_, O_GGC) WSP(float, NWSC_, O_NWSC) WSP(float, BIAS_, O_BIAS) WSP(float, SSQ_, O_SSQ) WSP(bf16_t, A2_, O_RKT)

DEV int lane_id() { unsigned m = ~0u; asm volatile("" : "+s"(m)); return (int)__builtin_amdgcn_mbcnt_hi(m, __builtin_amdgcn_mbcnt_lo(m, 0u)); }
DEV int launder_s(int v) { asm volatile("" : "+s"(v)); return v; }
DEV int get_tid(int wave_s) { return launder_s(wave_s) * 64 + lane_id(); }
#define XB_TMO      128
#define XB_XCNT(j)  (256  + 64 * (j))
#define XB_XSUB(j)  (1280 + 64 * (j))
#define XB_XGEN(j)  (2304 + 64 * (j))
#define XB_TOP      3328
#define XB_TOPGEN   3392
#define XCD_BAR_WORDS 3456
#define XB_SPIN_CAP (1u << 18)

__device__ __forceinline__ unsigned xb_ld(unsigned* p)              { return __hip_atomic_load(p, __ATOMIC_RELAXED, __HIP_MEMORY_SCOPE_AGENT); }
__device__ __forceinline__ unsigned xb_add(unsigned* p, unsigned v) { return __hip_atomic_fetch_add(p, v, __ATOMIC_RELAXED, __HIP_MEMORY_SCOPE_AGENT); }
__device__ __forceinline__ unsigned xb_xcc_id() { return (unsigned)__builtin_amdgcn_s_getreg((3 << 11) | 20) & 0xFu; }
#define XB_SPIN(cond, bar) do { unsigned _sp = 0; while (cond) { __builtin_amdgcn_s_sleep(1); \
    if ((++_sp & 255u) == 0u) { if (xb_ld(&(bar)[XB_TMO])) break; if (_sp > XB_SPIN_CAP) { atomicAdd(&(bar)[XB_TMO], 1u); break; } } } } while (0)

struct XcdBarrier {
    unsigned* bar; unsigned x;
    volatile LAS unsigned* st;
};

__device__ __forceinline__ XcdBarrier xcd_barrier_post(unsigned* bar, volatile LAS unsigned* st, int tid) {
    XcdBarrier b; b.bar = bar; b.x = xb_xcc_id(); b.st = st;
    if (tid == 0) (void)xb_add(&bar[XB_XCNT(b.x)], 1u);
    return b;
}
__device__ __forceinline__ void xcd_barrier_complete(unsigned* bar, unsigned x, unsigned& nloc, unsigned& nx) {
    const unsigned G = gridDim.x * gridDim.y * gridDim.z;
    unsigned sum, cnt, mine, sp = 0u;
    for (;;) {
        sum = 0u; cnt = 0u; mine = 0u;
#pragma unroll
        for (unsigned j = 0; j < 16; ++j) { const unsigned c = xb_ld(&bar[XB_XCNT(j)]); sum += c; cnt += (c > 0u) ? 1u : 0u; mine = (j == x) ? c : mine; }
        if (sum == G) break;
        __builtin_amdgcn_s_sleep(1);
        if ((++sp & 255u) == 0u) { if (xb_ld(&bar[XB_TMO])) break; if (sp > XB_SPIN_CAP) { atomicAdd(&bar[XB_TMO], 1u); break; } }
    }
    nloc = mine > 0u ? mine : 1u; nx = cnt > 0u ? cnt : 1u;
}

__device__ __forceinline__ void xcd_barrier(const XcdBarrier& b, int tid) {
    asm volatile("s_waitcnt vmcnt(0)" ::: "memory");
    __syncthreads();
    if (tid == 0) {
        unsigned* bar = b.bar; asm volatile("" : "+s"(bar)); unsigned bx = b.x; asm volatile("" : "+s"(bx));
        __builtin_amdgcn_s_waitcnt(0);
        unsigned nloc = b.st[0], nx = b.st[1];
        if (nloc == 0u) { xcd_barrier_complete(bar, bx, nloc, nx); b.st[0] = nloc; b.st[1] = nx; }
        const unsigned old = xb_add(&bar[XB_XSUB(bx)], 1u);
        const unsigned gen = old / nloc;
        if (old + 1u == (gen + 1u) * nloc) {
            __builtin_amdgcn_fence(__ATOMIC_RELEASE, "agent");
            asm volatile("s_waitcnt vmcnt(0)" ::: "memory");
            const unsigned og = xb_add(&bar[XB_TOP], 1u);
            const unsigned tg = og / nx;
            if (og + 1u == (tg + 1u) * nx) xb_add(&bar[XB_TOPGEN], 1u);
            else XB_SPIN(xb_ld(&bar[XB_TOPGEN]) == tg, bar);
            __builtin_amdgcn_fence(__ATOMIC_ACQUIRE, "agent");
            xb_add(&bar[XB_XGEN(bx)], 1u);
            asm volatile("s_waitcnt vmcnt(0)" ::: "memory");
        } else {
            XB_SPIN(xb_ld(&bar[XB_XGEN(bx)]) == gen, bar);
            __builtin_amdgcn_fence(__ATOMIC_ACQUIRE, "agent");
            asm volatile("s_waitcnt vmcnt(0)" ::: "memory");
        }
    }
    __syncthreads();
}

DEV float bf2f(bf16_t v) { return __uint_as_float(((unsigned)v) << 16); }
typedef __bf16 bf16v2 __attribute__((ext_vector_type(2)));
typedef float f32v2 __attribute__((ext_vector_type(2)));
DEV unsigned pkbf(float lo, float hi) { f32v2 v = {lo, hi}; return __builtin_bit_cast(unsigned, __builtin_convertvector(v, bf16v2)); }
DEV bf16_t f2bf(float f) { return (bf16_t)(pkbf(f, 0.f) & 0xffffu); }
DEV unsigned pk2(float lo, float hi) { return pkbf(lo, hi); }
DEV float siluf(float x) { return x * __builtin_amdgcn_rcpf(1.0f + __expf(-x)); }
DEV float sigmf(float x) { return __builtin_amdgcn_rcpf(1.0f + __expf(-x)); }
DEV float softplusf(float x) {
    const float t = __expf(-fabsf(x));
    const float l1p = t < 0.03125f ? t * (1.0f - t * (0.5f - t * (1.0f / 3.0f - 0.25f * t))) : __logf(1.0f + t);
    return fmaxf(x, 0.f) + l1p;
}
template <int CTRL> DEV float dpp_add(float v) {
    const int iv = __float_as_int(v);
    return v + __int_as_float(__builtin_amdgcn_update_dpp(iv, iv, CTRL, 0xF, 0xF, false));
}
DEV float wave_sum(float v) {
    v = dpp_add<0xB1>(v);
    v = dpp_add<0x4E>(v);
    v = dpp_add<0x141>(v);
    v = dpp_add<0x140>(v);
    const int iv = __float_as_int(v);
    return (__int_as_float(__builtin_amdgcn_readlane(iv, 0)) + __int_as_float(__builtin_amdgcn_readlane(iv, 16))) +
           (__int_as_float(__builtin_amdgcn_readlane(iv, 32)) + __int_as_float(__builtin_amdgcn_readlane(iv, 48)));
}
DEV int modrow(int R) { return R < NCR ? NB : (R - NCR) / SQ; }

DEV void transpose_block(const float* W, int K, int N, bf16_t* WT, int drow0, int k0, int n0, LAS float* tile, int tid) {
    {
        const int kq = tid >> 5, n4 = (tid & 31) * 4;
        const bool ok = n0 + n4 < N;
        const float* src = W + (size_t)(k0 + kq) * N + n0 + n4;
        f32x4 v[8];
#pragma unroll
        for (int i = 0; i < 8; ++i) v[i] = ok ? *(const f32x4*)(src + (size_t)(16 * i) * N) : (f32x4){0.f, 0.f, 0.f, 0.f};
#pragma unroll
        for (int i = 0; i < 8; ++i) { LAS float* d = tile + (16 * i + kq) * 129 + n4; d[0] = v[i].x; d[1] = v[i].y; d[2] = v[i].z; d[3] = v[i].w; }
    }
    __syncthreads();
    {
        const int c = tid & 15;
#pragma unroll
        for (int j = 0; j < 4; ++j) {
            const int n = (tid >> 4) + 32 * j;
            const LAS float* sp = tile + (8 * c) * 129 + n;
            u32x4 o;
            o.x = pk2(sp[0 * 129], sp[1 * 129]); o.y = pk2(sp[2 * 129], sp[3 * 129]); o.z = pk2(sp[4 * 129], sp[5 * 129]); o.w = pk2(sp[6 * 129], sp[7 * 129]);
            *(u32x4*)(WT + (size_t)(drow0 + n) * K + k0 + 8 * c) = o;
        }
    }
    __syncthreads();
}

DEV void ph_prologue(const DParams& p, LAS unsigned char* lds, int wave_s) {
    wave_s = launder_s(wave_s);
    const int tid = get_tid(wave_s), lane = tid & 63, wave = tid >> 6;
    const long gtid = (long)blockIdx.x * NT + tid, gsize = (long)gridDim.x * NT;
    {
        LAS float* cs = (LAS float*)lds;
        LAS float* red = (LAS float*)(lds + 9 * 1024 * 4);
        for (int i = tid; i < 9 * DM; i += NT) { const int r = i / DM, k = i % DM; cs[i] = siluf(r < NB ? p.c[r * DM + k] : lp(p.c_ctx)[k]); }
        __syncthreads();
        for (int task = blockIdx.x; task < 2 * 96; task += gridDim.x) {
            const int l = task / 96, col = (task % 96) * 64 + lane;
            const float* w = lp(p.ada_w) + (size_t)l * DM * NMOD * DM + col;
            float acc[9];
#pragma unroll
            for (int r = 0; r < 9; ++r) acc[r] = 0.f;
#pragma unroll 16
            for (int k = wave * 128; k < wave * 128 + 128; ++k) {
                const float wv = w[(size_t)k * NMOD * DM];
#pragma unroll
                for (int r = 0; r < 9; ++r) acc[r] += cs[r * DM + k] * wv;
            }
#pragma unroll
            for (int r = 0; r < 9; ++r) red[(wave * 9 + r) * 64 + lane] = acc[r];
            __syncthreads();
            for (int i = tid; i < 9 * 64; i += NT) {
                const int r = i / 64, cc = i % 64;
                float s = 0.f;
                for (int w8 = 0; w8 < 8; ++w8) s += red[(w8 * 9 + r) * 64 + cc];
                const int colg = (task % 96) * 64 + cc;
                MOD_(p)[((size_t)l * (NB + 1) + r) * NMOD * DM + colg] = s + lp(p.ada_b)[(size_t)l * NMOD * DM + colg];
            }
            __syncthreads();
        }
    }
    {
        if (gtid < 16) { const float rate = lp(p.ret_rate)[gtid]; ROPE_(p)[64 * 16 * 2 + gtid] = log1pf(-exp2f(-rate)) * 1.44269504088896f; }
        for (long i = gtid; i < 64 * 16; i += gsize) {
            const int pos = (int)(i / 16), f = (int)(i % 16);
            const double fr = pow(10000.0, -(double)f / 16.0), ang = (double)pos * fr;
            ROPE_(p)[i * 2 + 0] = (float)cos(ang); ROPE_(p)[i * 2 + 1] = (float)sin(ang);
        }
    }
    {
        LAS float* tile = (LAS float*)lds;
        unsigned* ctr = (unsigned*)(lp(p.ws) + O_CTR) + 32;
        volatile LAS unsigned* slot = (volatile LAS unsigned*)(lds + LDS_BYTES - 32);
        constexpr int I_IN = 8 * 24, I_OUT = 8 * 8, I_F1 = 8 * 44, I_F2 = 22 * 8, I_L = I_IN + I_OUT + I_F1 + I_F2;
        for (;;) {
            if (tid == 0) slot[0] = atomicAdd(ctr, 1u);
            __syncthreads();
            const int it = (int)slot[0];
            __syncthreads();
            if (it >= 2 * I_L) break;
            const int l = it / I_L; int r = it % I_L;
            if (r < I_IN) { const int kb = r / 24, nb = r % 24; transpose_block(lp(p.w_in) + (size_t)l * DM * INW, DM, INW, WIN_(p) + (size_t)l * NPAD * DM, nb * 128, kb * 128, nb * 128, tile, tid); continue; }
            r -= I_IN;
            if (r < I_OUT) { const int kb = r / 8, nb = r % 8; transpose_block(lp(p.w_out) + (size_t)l * 1024 * DM, 1024, DM, WOUT_(p) + (size_t)l * DM * 1024, nb * 128, kb * 128, nb * 128, tile, tid); continue; }
            r -= I_OUT;
            if (r < I_F1) {
                const int kb = r / 44, nb = r % 44, n0 = nb * 128;
                const int j = n0 < DFF ? n0 : n0 - DFF;
                const int drow = 256 * (j / 128) + (n0 < DFF ? 0 : 128);
                transpose_block(lp(p.w_ffn_in) + (size_t)l * DM * 2 * DFF, DM, 2 * DFF, WF1_(p) + (size_t)l * 2 * DFF * DM, drow, kb * 128, n0, tile, tid); continue;
            }
            r -= I_F1;
            { const int kb = r / 8, nb = r % 8; transpose_block(lp(p.w_ffn_out) + (size_t)l * DFF * DM, DFF, DM, WF2_(p) + (size_t)l * DM * DFF, nb * 128, kb * 128, nb * 128, tile, tid); }
        }
    }
}

DEV void ph_pre0(const DParams& p, LAS unsigned char* lds, int wave_s) {
    wave_s = launder_s(wave_s);
    const int tid = get_tid(wave_s), lane = tid & 63;
    const long gtid = (long)blockIdx.x * NT + tid, gsize = (long)gridDim.x * NT;
    for (long i = gtid; i < 2 * 2 * 9 * DM; i += gsize) {
        const int k = (int)(i % DM), m = (int)((i / DM) % 9), which = (int)((i / (9 * DM)) % 2), l = (int)(i / (2 * 9 * DM));
        const float nw = (which == 0 ? lp(p.norm_mix_w) : lp(p.norm_ffn_w))[l * DM + k];
        const float sc = MOD_(p)[((size_t)l * (NB + 1) + m) * NMOD * DM + (which == 0 ? 1 : 4) * DM + k];
        NWSC_(p)[i] = nw * (1.0f + sc);
    }
    {
        LAS float* shs = (LAS float*)lds;
        for (int vb = blockIdx.x; vb < 256; vb += gridDim.x) {
            const int l = vb >> 7, bb = vb & 127, which = bb < 43 ? 0 : 1, sub = which == 0 ? bb : bb - 43, nsub = which == 0 ? 43 : 85;
            const int N = which == 0 ? NPAD : 2 * DFF;
            const int c0 = (int)((long)N * sub / nsub), c1 = (int)((long)N * (sub + 1) / nsub);
            const bf16_t* Wt = which == 0 ? WIN_(p) + (size_t)l * NPAD * DM : WF1_(p) + (size_t)l * 2 * DFF * DM;
            __syncthreads();
            for (int i = tid; i < 9 * DM; i += NT) shs[i] = MOD_(p)[((size_t)l * (NB + 1) + i / DM) * NMOD * DM + (which == 0 ? 0 : 3) * DM + (i % DM)];
            __syncthreads();
            float sh[9][16];
#pragma unroll
            for (int m = 0; m < 9; ++m)
#pragma unroll
                for (int q = 0; q < 4; ++q) {
                    const f32x4 t4 = *(const LAS f32x4*)(shs + m * DM + (q >> 1) * 512 + 8 * lane + 4 * (q & 1));
                    sh[m][4 * q + 0] = t4.x; sh[m][4 * q + 1] = t4.y; sh[m][4 * q + 2] = t4.z; sh[m][4 * q + 3] = t4.w;
                }
            float* bo = BIAS_(p) + ((size_t)l * 2 + which) * 9 * 5632;
            for (int n = c0 + wave_s; n < c1; n += NW) {
                const u32x4 w0 = *(const u32x4*)(Wt + (size_t)n * DM + 8 * lane), w1 = *(const u32x4*)(Wt + (size_t)n * DM + 512 + 8 * lane);
                float wv[16];
#pragma unroll
                for (int j = 0; j < 4; ++j) { wv[2 * j] = __uint_as_float(w0[j] << 16); wv[2 * j + 1] = __uint_as_float(w0[j] & 0xffff0000u); wv[8 + 2 * j] = __uint_as_float(w1[j] << 16); wv[8 + 2 * j + 1] = __uint_as_float(w1[j] & 0xffff0000u); }
                float acc[9];
#pragma unroll
                for (int m = 0; m < 9; ++m) {
                    float a = 0.f;
#pragma unroll
                    for (int j = 0; j < 16; ++j) a += sh[m][j] * wv[j];
                    acc[m] = wave_sum(a);
                }
                if (lane < 9) {
                    float v = acc[0];
#pragma unroll
                    for (int m = 1; m < 9; ++m) v = lane == m ? acc[m] : v;
                    bo[(size_t)lane * 5632 + n] = v;
                }
            }
        }
        __syncthreads();
    }
    {
        const int gw = blockIdx.x * NW + wave_s, ngw = gridDim.x * NW;
        const float* nw = lp(p.norm_mix_w);
        for (int R = gw; R < ROWS; R += ngw) {
            const f32x4* xr = (const f32x4*)(R < NCR ? lp(p.ctx) + (size_t)R * DM : lp(p.x) + (size_t)(R - NCR) * DM) + lane;
            f32x4 v[4]; float sq = 0.f;
#pragma unroll
            for (int j = 0; j < 4; ++j) { v[j] = xr[64 * j]; sq += (v[j].x * v[j].x + v[j].y * v[j].y) + (v[j].z * v[j].z + v[j].w * v[j].w); }
            sq = wave_sum(sq);
            const f32x4* sc = (const f32x4*)(MOD_(p) + (size_t)modrow(R) * NMOD * DM + 1 * DM) + lane;
            const f32x4* w4 = (const f32x4*)nw + lane;
            unsigned long long* o8 = (unsigned long long*)(H_(p) + (size_t)R * DM) + lane;
#pragma unroll
            for (int j = 0; j < 4; ++j) {
                const f32x4 a = v[j] * w4[64 * j] * (sc[64 * j] + 1.0f);
                o8[64 * j] = (unsigned long long)pk2(a.x, a.y) | ((unsigned long long)pk2(a.z, a.w) << 32);
            }
            if (lane < 16) SSQ_(p)[(size_t)R * 16 + lane] = lane == 0 ? sq : 0.f;
        }
    }
}

DEV float shfl_xor_l(float v, int m) { return __int_as_float(__builtin_amdgcn_ds_bpermute((lane_id() ^ m) << 2, __float_as_int(v))); }
DEV void rows_rstd(const float* ssq, int R0, int fq, float (&rs)[2][4]) {
    f32x4 q[2][4];
#pragma unroll
    for (int ai = 0; ai < 2; ++ai)
#pragma unroll
        for (int m = 0; m < 4; ++m) q[ai][m] = *(const f32x4*)(ssq + (size_t)(R0 + ai * 128 + m * 16) * 16 + 4 * fq);
#pragma unroll
    for (int ai = 0; ai < 2; ++ai)
#pragma unroll
        for (int m = 0; m < 4; ++m) {
            float a = (q[ai][m].x + q[ai][m].y) + (q[ai][m].z + q[ai][m].w);
            a += shfl_xor_l(a, 16); a += shfl_xor_l(a, 32);
            rs[ai][m] = __builtin_amdgcn_rsqf(a * (1.0f / DM) + 1e-6f);
        }
}
struct EpiP {
    static constexpr bool PERM = true, AFTER_DRAIN = false;
    bf16_t* O; int ldc; const float* ssq; const float* bias;
    DEV void operator()(const f32x4 (&acc)[2][2][4][2], const Unit& u, int wr, int wc, int fr, int fq) const {
        const int row0 = u.pm * 256 + wr * 64 + fr, col0 = u.pn * 256 + wc * 32 + 8 * fq;
        const float* bp = bias + (size_t)modrow(u.pm * 256) * 5632 + col0;
        f32x4 bv[2][2];
#pragma unroll
        for (int bj = 0; bj < 2; ++bj)
#pragma unroll
            for (int n = 0; n < 2; ++n) bv[bj][n] = *(const f32x4*)(bp + bj * 128 + 4 * n);
        float rs[2][4];
        rows_rstd(ssq, row0, fq, rs);
#pragma unroll
        for (int ai = 0; ai < 2; ++ai)
#pragma unroll
            for (int m = 0; m < 4; ++m) {
                bf16_t* rowp = O + (size_t)(row0 + ai * 128 + m * 16) * ldc + col0;
#pragma unroll
                for (int bj = 0; bj < 2; ++bj) {
                    const f32x4 v0 = acc[ai][bj][m][0] * rs[ai][m] + bv[bj][0], v1 = acc[ai][bj][m][1] * rs[ai][m] + bv[bj][1];
                    u32x4 w; w.x = pg8::cvt_pk_bf16(v0[0], v0[1]); w.y = pg8::cvt_pk_bf16(v0[2], v0[3]); w.z = pg8::cvt_pk_bf16(v1[0], v1[1]); w.w = pg8::cvt_pk_bf16(v1[2], v1[3]);
                    if (col0 + bj * 128 < INW) *(u32x4*)(rowp + bj * 128) = w;
                }
            }
    }
};
struct EpiSwiglu {
    static constexpr bool PERM = true, AFTER_DRAIN = false;
    bf16_t* O; int ldc; const float* ssq; const float* bias; int row_base;
    DEV void operator()(const f32x4 (&acc)[2][2][4][2], const Unit& u, int wr, int wc, int fr, int fq) const {
        const int row0 = u.pm * 256 + wr * 64 + fr, col0 = u.pn * 128 + wc * 32 + 8 * fq;
        const float* bp = bias + (size_t)modrow(row_base + u.pm * 256) * 5632 + u.pn * 256 + wc * 32 + 8 * fq;
        f32x4 bg[2], bu[2];
#pragma unroll
        for (int n = 0; n < 2; ++n) { bg[n] = *(const f32x4*)(bp + 4 * n); bu[n] = *(const f32x4*)(bp + 128 + 4 * n); }
        float rs[2][4];
        rows_rstd(ssq, row_base + row0, fq, rs);
#pragma unroll
        for (int ai = 0; ai < 2; ++ai)
#pragma unroll
            for (int m = 0; m < 4; ++m) {
                bf16_t* rowp = O + (size_t)(row0 + ai * 128 + m * 16) * ldc + col0;
                float v[8];
#pragma unroll
                for (int n = 0; n < 2; ++n)
#pragma unroll
                    for (int i = 0; i < 4; ++i) { const float g = acc[ai][0][m][n][i] * rs[ai][m] + bg[n][i], up = acc[ai][1][m][n][i] * rs[ai][m] + bu[n][i]; v[n * 4 + i] = g * __builtin_amdgcn_rcpf(1.0f + __expf(-g)) * up; }
                u32x4 w; w.x = pg8::cvt_pk_bf16(v[0], v[1]); w.y = pg8::cvt_pk_bf16(v[2], v[3]); w.z = pg8::cvt_pk_bf16(v[4], v[5]); w.w = pg8::cvt_pk_bf16(v[6], v[7]);
                *(u32x4*)rowp = w;
            }
    }
};
struct EpiRes {
    static constexpr bool PERM = true, AFTER_DRAIN = false;
    const float* SL; const float* SC; float* XL; float* XC; const float* modl; int gidx; int row_base;
    const float* nwsc;
    bf16_t* An;
    float* ssq;
    DEV void operator()(const f32x4 (&acc)[2][2][4][2], const Unit& u, int wr, int wc, int fr, int fq) const {
        const int row0 = row_base + u.pm * 256 + wr * 64 + fr, col0 = u.pn * 256 + wc * 32 + 8 * fq;
        const int mr = modrow(row_base + u.pm * 256);
        const float* g = modl + (size_t)mr * NMOD * DM + gidx * DM + col0;
        const bool isc = (row_base + u.pm * 256) < NCR;
        const size_t xb = (isc ? (size_t)row0 * DM : (size_t)(row0 - NCR) * DM) + col0;
        const float* xs = (isc ? SC : SL) + xb;
        float* xd = (isc ? XC : XL) + xb;
        f32x4 gv[2][2], nv[2][2];
#pragma unroll
        for (int bj = 0; bj < 2; ++bj)
#pragma unroll
            for (int n = 0; n < 2; ++n) {
                gv[bj][n] = *(const f32x4*)(g + bj * 128 + n * 4);
                nv[bj][n] = nwsc ? *(const f32x4*)(nwsc + (size_t)mr * DM + col0 + bj * 128 + n * 4) : (f32x4){0.f, 0.f, 0.f, 0.f};
            }
#pragma unroll
        for (int am = 0; am < 4; ++am) {
            const int ai = am >> 1, m0 = (am & 1) * 2;
            f32x4 xo[2][2][2];
#pragma unroll
            for (int mm = 0; mm < 2; ++mm)
#pragma unroll
                for (int bj = 0; bj < 2; ++bj)
#pragma unroll
                    for (int n = 0; n < 2; ++n) xo[mm][bj][n] = *(const f32x4*)(xs + (size_t)(ai * 128 + (m0 + mm) * 16) * DM + bj * 128 + n * 4);
            asm volatile("" ::: "memory");
#pragma unroll
            for (int mm = 0; mm < 2; ++mm) {
                const int m = m0 + mm;
                const int R = row0 + ai * 128 + m * 16;
                const size_t ro = (size_t)(ai * 128 + m * 16) * DM;
                float sq = 0.f;
#pragma unroll
                for (int bj = 0; bj < 2; ++bj) {
                    const f32x4 x0 = xo[mm][bj][0] + gv[bj][0] * acc[ai][bj][m][0], x1 = xo[mm][bj][1] + gv[bj][1] * acc[ai][bj][m][1];
                    *(f32x4*)(xd + ro + bj * 128) = x0; *(f32x4*)(xd + ro + bj * 128 + 4) = x1;
                    sq += ((x0.x * x0.x + x0.y * x0.y) + (x0.z * x0.z + x0.w * x0.w)) + ((x1.x * x1.x + x1.y * x1.y) + (x1.z * x1.z + x1.w * x1.w));
                    if (nwsc) {
                        const f32x4 a0 = x0 * nv[bj][0], a1 = x1 * nv[bj][1];
                        u32x4 w; w.x = pg8::cvt_pk_bf16(a0.x, a0.y); w.y = pg8::cvt_pk_bf16(a0.z, a0.w); w.z = pg8::cvt_pk_bf16(a1.x, a1.y); w.w = pg8::cvt_pk_bf16(a1.z, a1.w);
                        *(u32x4*)(An + (size_t)R * DM + col0 + bj * 128) = w;
                    }
                }
                sq += shfl_xor_l(sq, 16); sq += shfl_xor_l(sq, 32);
                if (fq == 0) ssq[(size_t)R * 16 + u.pn * 4 + wc] = sq;
            }
        }
    }
};

typedef float f32x16 __attribute__((ext_vector_type(16)));
using pg8::bf16x8;
#define MFMA32(a, b, c) __builtin_amdgcn_mfma_f32_32x32x16_bf16((a), (b), (c), 0, 0, 0)
DEV float bflo(unsigned w) { return __uint_as_float(w << 16); }
DEV float bfhi(unsigned w) { return __uint_as_float(w & 0xffff0000u); }
DEV float xor32_max(float v) { const auto r = __builtin_amdgcn_permlane32_swap(__float_as_uint(v), __float_as_uint(v), false, false); return fmaxf(__uint_as_float(r[0]), __uint_as_float(r[1])); }
DEV float xor32_sum(float v) { const auto r = __builtin_amdgcn_permlane32_swap(__float_as_uint(v), __float_as_uint(v), false, false); return __uint_as_float(r[0]) + __uint_as_float(r[1]); }
DEV float shfl_xor32(float v) { const int idx = (lane_id() ^ 32) << 2; return __int_as_float(__builtin_amdgcn_ds_bpermute(idx, __float_as_int(v))); }
#define LDS_BARRIER() do { asm volatile("s_waitcnt lgkmcnt(0)" ::: "memory"); __builtin_amdgcn_s_barrier(); asm volatile("" ::: "memory"); } while (0)
DEV int kswz(int r) { return (r & ~12) | ((r & 4) << 1) | ((r & 8) >> 1); }

DEV void swa_unit(const DParams& p, int layer, int unit, LAS unsigned char* lds, int tid, int wave_s) {
    const bool lat = unit < NB * 2 * 64;
    int b, kvh, qb;
    if (lat) { b = unit / 128; kvh = (unit / 64) & 1; qb = unit % 64; }
    else { const int u = unit - NB * 2 * 64; b = u / 8; kvh = (u / 4) & 1; qb = u % 4; }
    const int lt_lo = lat ? (qb - 2 < 0 ? 0 : qb - 2) : 0, lt_hi = lat ? (qb + 2 > 63 ? 63 : qb + 2) : -1;
    const int nt = 4 + (lt_hi - lt_lo + 1);
    {
        const bf16_t* kt = KT_(p) + (size_t)(b * 2 + kvh) * 68 * 4096;
        const bf16_t* vt = VT_(p) + (size_t)(b * 2 + kvh) * 68 * 4096;
        for (int i = 0; i < nt; ++i) {
            const int tile = i < 4 ? i : 4 + lt_lo + (i - 4);
            const u32x4 kq = *(const u32x4*)(kt + (size_t)tile * 4096 + tid * 8);
            const u32x4 vq = *(const u32x4*)(vt + (size_t)tile * 4096 + tid * 8);
            *(LAS u32x4*)(lds + i * 16384 + tid * 16) = kq;
            *(LAS u32x4*)(lds + i * 16384 + 8192 + tid * 16) = vq;
        }
    }
    __syncthreads();
    const int lane = tid & 63, r = lane & 31, h = lane >> 5;
    const int g = wave_s >> 1, sb = wave_s & 1, hq = kvh * 4 + g;
    const int qloc = qb * 64 + 32 * sb + r;
    const int qrow = lat ? NCR + b * SQ + qloc : b * CTX + qloc;
    bf16x8 qf[4];
    {
        const bf16_t* qp = P_(p) + (size_t)qrow * PST + C_SQ + hq * 64 + 8 * h;
        float qv[4][8];
#pragma unroll
        for (int s4 = 0; s4 < 4; ++s4) {
            const u32x4 w = *(const u32x4*)(qp + 16 * s4);
#pragma unroll
            for (int j = 0; j < 8; ++j) qv[s4][j] = (j & 1) ? bfhi(w[j >> 1]) : bflo(w[j >> 1]);
        }
        if (lat) {
#pragma unroll
            for (int a = 0; a < 2; ++a) {
                const int pos = a == 0 ? qloc / 64 : qloc % 64;
                const float* rp = ROPE_(p) + (pos * 16 + 8 * h) * 2;
#pragma unroll
                for (int j = 0; j < 8; ++j) {
                    const float cs = rp[2 * j], sn = rp[2 * j + 1], t1 = qv[2 * a][j], t2 = qv[2 * a + 1][j];
                    qv[2 * a][j] = t1 * cs - t2 * sn; qv[2 * a + 1][j] = t1 * sn + t2 * cs;
                }
            }
        }
        const float qs = 0.125f * 1.44269504088896f;
#pragma unroll
        for (int s4 = 0; s4 < 4; ++s4) {
            u32x4 w;
            w.x = pkbf(qv[s4][0] * qs, qv[s4][1] * qs); w.y = pkbf(qv[s4][2] * qs, qv[s4][3] * qs);
            w.z = pkbf(qv[s4][4] * qs, qv[s4][5] * qs); w.w = pkbf(qv[s4][6] * qs, qv[s4][7] * qs);
            qf[s4] = __builtin_bit_cast(bf16x8, w);
        }
    }
    f32x16 O0, O1;
#pragma unroll
    for (int i = 0; i < 16; ++i) { O0[i] = 0.f; O1[i] = 0.f; }
    float m = lp(p.swa_sinks)[layer * 8 + hq] * 1.44269504088896f, l = 1.0f;
    const int ksw = ((r >> 1) & 7);
    for (int ti = 0; ti < nt; ++ti) {
        const LAS unsigned char* Kt = lds + ti * 16384;
        const LAS unsigned char* Vt = Kt + 8192;
        f32x16 x0, x1;
#pragma unroll
        for (int i = 0; i < 16; ++i) { x0[i] = 0.f; x1[i] = 0.f; }
#pragma unroll
        for (int s4 = 0; s4 < 4; ++s4) {
            const bf16x8 k0 = *(const LAS bf16x8*)(Kt + r * 128 + (((2 * s4 + h) ^ ksw) * 16));
            const bf16x8 k1 = *(const LAS bf16x8*)(Kt + (32 + r) * 128 + (((2 * s4 + h) ^ ksw) * 16));
            x0 = MFMA32(k0, qf[s4], x0);
            x1 = MFMA32(k1, qf[s4], x1);
        }
        if (ti >= 4) {
            const int lt = lt_lo + (ti - 4);
            if (lt == qb - 2 || lt == qb + 2) {
                const int kbase = lt * 64 + 4 * h - qloc;
#pragma unroll
                for (int i = 0; i < 16; ++i) {
                    const int d0 = kbase + (i & 3) + 8 * (i >> 2), d1 = d0 + 32;
                    if (d0 > 128 || d0 < -128) x0[i] = -1e30f;
                    if (d1 > 128 || d1 < -128) x1[i] = -1e30f;
                }
            }
        }
        float mx = x0[0];
#pragma unroll
        for (int i = 1; i < 16; ++i) mx = fmaxf(mx, x0[i]);
#pragma unroll
        for (int i = 0; i < 16; ++i) mx = fmaxf(mx, x1[i]);
        mx = xor32_max(mx);
        const float mn = fmaxf(m, mx), alpha = __builtin_amdgcn_exp2f(m - mn);
        m = mn;
        float rs = 0.f;
#pragma unroll
        for (int i = 0; i < 16; ++i) { x0[i] = __builtin_amdgcn_exp2f(x0[i] - mn); x1[i] = __builtin_amdgcn_exp2f(x1[i] - mn); rs += x0[i] + x1[i]; }
        rs = xor32_sum(rs);
        l = l * alpha + rs;
#pragma unroll
        for (int i = 0; i < 16; ++i) { O0[i] *= alpha; O1[i] *= alpha; }
#pragma unroll
        for (int kg = 0; kg < 2; ++kg)
#pragma unroll
            for (int s2 = 0; s2 < 2; ++s2) {
                u32x4 w;
                if (kg == 0) { w.x = pkbf(x0[8 * s2 + 0], x0[8 * s2 + 1]); w.y = pkbf(x0[8 * s2 + 2], x0[8 * s2 + 3]); w.z = pkbf(x0[8 * s2 + 4], x0[8 * s2 + 5]); w.w = pkbf(x0[8 * s2 + 6], x0[8 * s2 + 7]); }
                else { w.x = pkbf(x1[8 * s2 + 0], x1[8 * s2 + 1]); w.y = pkbf(x1[8 * s2 + 2], x1[8 * s2 + 3]); w.z = pkbf(x1[8 * s2 + 4], x1[8 * s2 + 5]); w.w = pkbf(x1[8 * s2 + 6], x1[8 * s2 + 7]); }
                const bf16x8 pf = __builtin_bit_cast(bf16x8, w);
                const int ch = 4 * kg + 2 * s2 + h;
                const bf16x8 v0 = *(const LAS bf16x8*)(Vt + r * 128 + ((ch ^ ksw) * 16));
                const bf16x8 v1 = *(const LAS bf16x8*)(Vt + (32 + r) * 128 + ((ch ^ ksw) * 16));
                O0 = MFMA32(v0, pf, O0);
                O1 = MFMA32(v1, pf, O1);
            }
    }
    {
        const float inv = 1.0f / l;
        bf16_t* op = H_(p) + (size_t)qrow * 1024 + 256 + hq * 64 + 4 * h;
#pragma unroll
        for (int g4 = 0; g4 < 4; ++g4) {
            uint2 w0, w1;
            w0.x = pkbf(O0[4 * g4] * inv, O0[4 * g4 + 1] * inv); w0.y = pkbf(O0[4 * g4 + 2] * inv, O0[4 * g4 + 3] * inv);
            w1.x = pkbf(O1[4 * g4] * inv, O1[4 * g4 + 1] * inv); w1.y = pkbf(O1[4 * g4 + 2] * inv, O1[4 * g4 + 3] * inv);
            *(uint2*)(op + 8 * g4) = w0;
            *(uint2*)(op + 32 + 8 * g4) = w1;
        }
    }
    __syncthreads();
}

typedef float f32x4v __attribute__((ext_vector_type(4)));
#define MFMA16(a, b, c) __builtin_amdgcn_mfma_f32_16x16x32_bf16((a), (b), (c), 0, 0, 0)
DEV float ex2(float x) { return __builtin_amdgcn_exp2f(x); }
template <int CTRL> DEV float dpp_mov(float v) { const int iv = __float_as_int(v); return __int_as_float(__builtin_amdgcn_update_dpp(iv, iv, CTRL, 0xF, 0xF, false)); }
DEV float row16_sum(float v) {
    v += dpp_mov<0xB1>(v); v += dpp_mov<0x4E>(v); v += dpp_mov<0x141>(v); v += dpp_mov<0x140>(v); return v;
}
DEV int chunk_row0(int b, int n) { return n < 4 ? b * CTX + n * 64 : NCR + b * SQ + (n - 4) * 64; }
DEV void load_rope8(const DParams& p, const bf16_t* hp, int c, bool lat, int t, float scale, float (&o)[8]) {
    const u32x4 kv = *(const u32x4*)(hp + 8 * c);
#pragma unroll
    for (int j = 0; j < 8; ++j) o[j] = (j & 1) ? bfhi(kv[j >> 1]) : bflo(kv[j >> 1]);
    if (lat) {
        const u32x4 pv = *(const u32x4*)(hp + 8 * (c ^ 2));
        const int pos = (c >> 2) == 0 ? t / 64 : t % 64;
        const float* rp = ROPE_(p) + (pos * 16 + 8 * (c & 1)) * 2;
        const bool first = (c & 2) == 0;
        f32x4 rt[4];
#pragma unroll
        for (int q4 = 0; q4 < 4; ++q4) rt[q4] = *(const f32x4*)(rp + 4 * q4);
#pragma unroll
        for (int j = 0; j < 8; ++j) {
            const float oth = (j & 1) ? bfhi(pv[j >> 1]) : bflo(pv[j >> 1]);
            const float cs = rt[j >> 1][2 * (j & 1)], sn = rt[j >> 1][2 * (j & 1) + 1];
            o[j] = first ? o[j] * cs - oth * sn : oth * sn + o[j] * cs;
        }
    }
#pragma unroll
    for (int j = 0; j < 8; ++j) o[j] *= scale;
}
DEV u32x4 pack8(const float (&o)[8]) { u32x4 w; w.x = pkbf(o[0], o[1]); w.y = pkbf(o[2], o[3]); w.z = pkbf(o[4], o[5]); w.w = pkbf(o[6], o[7]); return w; }

DEV float ret_lg2(const DParams& p, int layer, int dir, int h) { return ROPE_(p)[64 * 16 * 2 + layer * 8 + dir * 4 + h]; }
struct RetOps { u32x4 kw[2]; bf16x8 bq[2][2]; };
DEV int chain_chunk(int dir, int step) { return dir == 0 ? step : (step < 4 ? 3 - step : 67 - (step - 4)); }
DEV void ret_ops_load(RetOps& o, const bf16_t* rkt, const bf16_t* rvt, int bh, int dir, int step, int it, int jt0, int lr, int lq) {
    const size_t rec = (size_t)bh * 68 + chain_chunk(dir, step);
#pragma unroll
    for (int ks = 0; ks < 2; ++ks) {
        o.kw[ks] = *(const u32x4*)(rkt + rec * 4096 + (16 * it + lr) * 64 + 32 * ks + 8 * lq);
#pragma unroll
        for (int t = 0; t < 2; ++t) o.bq[t][ks] = *(const bf16x8*)(rvt + rec * 4096 + (16 * (jt0 + t) + lr) * 64 + 32 * ks + 8 * lq);
    }
}
DEV void ret_scan_chain(const DParams& p, int layer, int chain, int tid, int wave_s) {
    const int dir = chain & 1, bh = chain >> 1, h = bh & 3;
    const int lane = tid & 63, lr = lane & 15, lq = lane >> 4, it = wave_s >> 1, jt0 = 2 * (wave_s & 1);
    const float lg2 = ret_lg2(p, layer, dir, h), g64 = ex2(64.f * lg2);
    float dec[2][8];
#pragma unroll
    for (int ks = 0; ks < 2; ++ks)
#pragma unroll
        for (int j = 0; j < 8; ++j) { const int tok = 32 * ks + 8 * lq + j; dec[ks][j] = ex2(lg2 * (float)(dir == 0 ? 63 - tok : tok)); }
    const bf16_t* rkt = RKT_(p); const bf16_t* rvt = RVT_(p); bf16_t* rst = RST_(p);
    f32x4v S[2];
#pragma unroll
    for (int t = 0; t < 2; ++t) S[t] = (f32x4v){0.f, 0.f, 0.f, 0.f};
    RetOps o0, o1, o2, o3;
    ret_ops_load(o0, rkt, rvt, bh, dir, 0, it, jt0, lr, lq); ret_ops_load(o1, rkt, rvt, bh, dir, 1, it, jt0, lr, lq);
    ret_ops_load(o2, rkt, rvt, bh, dir, 2, it, jt0, lr, lq); ret_ops_load(o3, rkt, rvt, bh, dir, 3, it, jt0, lr, lq);
#define RET_STEP(O, STEP) do { \
        const size_t srec = (size_t)chain * 68 + chain_chunk(dir, (STEP)); \
        _Pragma("unroll") for (int t = 0; t < 2; ++t) { u32x2 w; w.x = pkbf(S[t][0], S[t][1]); w.y = pkbf(S[t][2], S[t][3]); \
            *(u32x2*)(rst + srec * 4096 + (16 * (jt0 + t) + lr) * 64 + 16 * it + 4 * lq) = w; } \
        bf16x8 a_[2]; \
        _Pragma("unroll") for (int ks = 0; ks < 2; ++ks) { float kv[8]; \
            _Pragma("unroll") for (int j = 0; j < 8; ++j) kv[j] = ((j & 1) ? bfhi(O.kw[ks][j >> 1]) : bflo(O.kw[ks][j >> 1])) * dec[ks][j]; \
            a_[ks] = __builtin_bit_cast(bf16x8, pack8(kv)); } \
        _Pragma("unroll") for (int t = 0; t < 2; ++t) { S[t] = S[t] * g64; \
            _Pragma("unroll") for (int ks = 0; ks < 2; ++ks) S[t] = MFMA16(a_[ks], O.bq[t][ks], S[t]); } \
        if ((STEP) + 4 < 68) ret_ops_load(O, rkt, rvt, bh, dir, (STEP) + 4, it, jt0, lr, lq); \
    } while (0)
#pragma unroll
    for (int step = 0; step < 68; step += 4) { RET_STEP(o0, step); RET_STEP(o1, step + 1); RET_STEP(o2, step + 2); RET_STEP(o3, step + 3); }
#undef RET_STEP
}

DEV void gdn_conv8(const float* cw, const bf16_t* hp, int chan, bool hasp, bool hasn, float (&o)[8]) {
    const u32x4 cur = *(const u32x4*)hp;
    u32x4 prv = (u32x4){0u, 0u, 0u, 0u}, nxt = prv;
    if (hasp) prv = *(const u32x4*)(hp - PST);
    if (hasn) nxt = *(const u32x4*)(hp + PST);
    f32x4 w[3][2];
#pragma unroll
    for (int t3 = 0; t3 < 3; ++t3) { w[t3][0] = *(const f32x4*)(cw + t3 * 768 + chan); w[t3][1] = *(const f32x4*)(cw + t3 * 768 + chan + 4); }
#pragma unroll
    for (int j = 0; j < 8; ++j) {
        const float a = ((j & 1) ? bfhi(prv[j >> 1]) : bflo(prv[j >> 1])) * w[0][j >> 2][j & 3] + ((j & 1) ? bfhi(cur[j >> 1]) : bflo(cur[j >> 1])) * w[1][j >> 2][j & 3] +
                        ((j & 1) ? bfhi(nxt[j >> 1]) : bflo(nxt[j >> 1])) * w[2][j >> 2][j & 3];
        o[j] = a * __builtin_amdgcn_rcpf(1.0f + __expf(-a));
    }
}
DEV float oct_sum(float v) { v += dpp_mov<0xB1>(v); v += dpp_mov<0x4E>(v); v += dpp_mov<0x141>(v); return v; }
DEV void l2norm8(float (&o)[8], float extra) {
    float ss = 0.f;
#pragma unroll
    for (int j = 0; j < 8; ++j) ss += o[j] * o[j];
    const float sc = extra * __builtin_amdgcn_rsqf(oct_sum(ss) + 1e-6f);
#pragma unroll
    for (int j = 0; j < 8; ++j) o[j] *= sc;
}


struct GdnPre { u32x4 kc[3], vc[3]; float ga, gb; };
DEV void gdn_pre_load(GdnPre& o, const DParams& p, int task, int tid) {
    const int n = task % 68, bh = task / 68, b = bh >> 2, h = bh & 3;
    const int row0 = chunk_row0(b, n), r = tid >> 3, c = tid & 7;
    const int slen = n < 4 ? CTX : SQ, t0 = n < 4 ? n * 64 : (n - 4) * 64;
    const bf16_t* prow = P_(p) + (size_t)(row0 + r) * PST;
    const bool hasp = t0 + r > 0, hasn = t0 + r + 1 < slen;
    const u32x4 z = (u32x4){0u, 0u, 0u, 0u};
    const bf16_t* kp = prow + C_GK + h * 64 + 8 * c;
    const bf16_t* vp = prow + C_GV + h * 64 + 8 * c;
    o.kc[1] = *(const u32x4*)kp; o.vc[1] = *(const u32x4*)vp;
    o.kc[0] = z; o.vc[0] = z; o.kc[2] = z; o.vc[2] = z;
    if (hasp) { o.kc[0] = *(const u32x4*)(kp - PST); o.vc[0] = *(const u32x4*)(vp - PST); }
    if (hasn) { o.kc[2] = *(const u32x4*)(kp + PST); o.vc[2] = *(const u32x4*)(vp + PST); }
    o.ga = 0.f; o.gb = 0.f;
    if (tid < 128) {
        const int dir = tid >> 6, i = tid & 63;
        const bf16_t* pr = P_(p) + (size_t)(row0 + i) * PST;
        o.ga = bf2f(pr[C_GA + dir * 4 + h]); o.gb = bf2f(pr[C_GB + dir * 4 + h]);
    }
}
DEV void conv8_regs(const float* cw, const u32x4 (&x)[3], int chan, float (&o)[8]) {
    f32x4 w[3][2];
#pragma unroll
    for (int t3 = 0; t3 < 3; ++t3) { w[t3][0] = *(const f32x4*)(cw + t3 * 768 + chan); w[t3][1] = *(const f32x4*)(cw + t3 * 768 + chan + 4); }
#pragma unroll
    for (int j = 0; j < 8; ++j) {
        const float a = ((j & 1) ? bfhi(x[0][j >> 1]) : bflo(x[0][j >> 1])) * w[0][j >> 2][j & 3] + ((j & 1) ? bfhi(x[1][j >> 1]) : bflo(x[1][j >> 1])) * w[1][j >> 2][j & 3] +
                        ((j & 1) ? bfhi(x[2][j >> 1]) : bflo(x[2][j >> 1])) * w[2][j >> 2][j & 3];
        o[j] = a * __builtin_amdgcn_rcpf(1.0f + __expf(-a));
    }
}
DEV float shfl_lane(float v, int src) { return __int_as_float(__builtin_amdgcn_ds_bpermute(src << 2, __float_as_int(v))); }

DEV void gdn_prep_task(const DParams& p, int layer, int task, int next_task, GdnPre& pre, LAS unsigned char* lds, int tid, int wave_s) {
    const int n = task % 68, bh = task / 68, h = bh & 3;
    const int r = tid >> 3, c = tid & 7;
    LAS bf16_t* kk = (LAS bf16_t*)lds;
    LAS bf16_t* kT = kk + 64 * 72;
    LAS bf16_t* vv = kT + 64 * 72;
    constexpr int MS = 65, XS = 129;
    LAS float* M0 = (LAS float*)(vv + 64 * 72);
    LAS float* M1 = M0 + 64 * MS;
    LAS float* gs = M1 + 64 * MS;
    LAS float* xs = gs + 640;
    const float* cw = lp(p.gdn_conv_w) + (size_t)layer * 3 * 768;
    const int lane = tid & 63, lr = lane & 15, lq = lane >> 4;
    {
        float o[8];
        conv8_regs(cw, pre.kc, 256 + h * 64 + 8 * c, o);
        l2norm8(o, 1.0f);
        *(LAS u32x4*)(kk + r * 72 + 8 * c) = pack8(o);
#pragma unroll
        for (int j = 0; j < 8; ++j) kT[(8 * c + j) * 72 + (r ^ (8 * c))] = f2bf(o[j]);
        conv8_regs(cw, pre.vc, 512 + h * 64 + 8 * c, o);
        *(LAS u32x4*)(vv + r * 72 + 8 * c) = pack8(o);
        if (tid < 128) {
            const int dir = wave_s;
            const float arate = __expf(lp(p.gdn_a_log)[layer * 8 + dir * 4 + h]), dtb = lp(p.gdn_dt_bias)[layer * 8 + dir * 4 + h];
            const float g = -arate * softplusf(pre.ga + dtb), bt = sigmf(pre.gb);
            float v = shfl_lane(g, dir ? 63 - lane : lane);
            const int lid = lane_id();
#pragma unroll
            for (int off = 1; off < 64; off <<= 1) { const float t = shfl_lane(v, lid - off); if (lid >= off) v += t; }
            const float gc = shfl_lane(v, dir ? 63 - lane : lane);
            gs[128 + dir * 64 + lane] = bt; gs[256 + dir * 64 + lane] = gc;
            gs[384 + dir * 128 + lane] = bt; gs[384 + dir * 128 + 64 + lane] = bt * __expf(gc);
        }
    }
    if (next_task >= 0) gdn_pre_load(pre, p, next_task, tid);
    __syncthreads();
#pragma unroll
    for (int tt = 0; tt < 2; ++tt) {
        const int t = 2 * wave_s + tt, it = t >> 2, jt = t & 3;
        f32x4v acc = (f32x4v){0.f, 0.f, 0.f, 0.f};
#pragma unroll
        for (int ks = 0; ks < 2; ++ks)
            acc = MFMA16(*(const LAS bf16x8*)(kk + (16 * it + lr) * 72 + 32 * ks + 8 * lq), *(const LAS bf16x8*)(kk + (16 * jt + lr) * 72 + 32 * ks + 8 * lq), acc);
#pragma unroll
        for (int rg = 0; rg < 4; ++rg) {
            const int i = 16 * it + 4 * lq + rg, j = 16 * jt + lr;
            if (i > j) M0[j * MS + i] = -gs[128 + i] * acc[rg] * __expf(gs[256 + i] - gs[256 + j]);
            if (i < j) M1[(63 - j) * MS + (63 - i)] = -gs[192 + i] * acc[rg] * __expf(gs[320 + i] - gs[320 + j]);
        }
    }
    __syncthreads();
#define MFMA4F(a, b, c) __builtin_amdgcn_mfma_f32_16x16x4f32((a), (b), (c), 0, 0, 0)
    LAS float* DI = xs + 2 * 64 * XS;
    {
        const int d = wave_s >> 2, B = wave_s & 3;
        const LAS float* Mb = (d ? M1 : M0) + (16 * B) * MS + 16 * B;
        f32x4v PU, QU, EY;
        {
#pragma unroll
            for (int rg = 0; rg < 4; ++rg) {
                const int kx = 4 * lq + rg;
                const float pv = Mb[kx * MS + lr], qv = Mb[lr * MS + kx];
                QU[rg] = kx > lr ? qv : 0.f;
                PU[rg] = lr > kx ? pv : 0.f;
                EY[rg] = kx == lr ? 1.f : 0.f;
            }
        }
        const f32x4v Z4 = (f32x4v){0.f, 0.f, 0.f, 0.f};
        f32x4v PU2 = Z4, QU2 = Z4, PU4 = Z4, QU4 = Z4, QU8 = Z4, T1 = Z4, T2 = Z4, T3 = Z4;
#pragma unroll
        for (int rg = 0; rg < 4; ++rg) { PU2 = MFMA4F(QU[rg], PU[rg], PU2); QU2 = MFMA4F(PU[rg], QU[rg], QU2); }
#pragma unroll
        for (int rg = 0; rg < 4; ++rg) { PU4 = MFMA4F(QU2[rg], PU2[rg], PU4); QU4 = MFMA4F(PU2[rg], QU2[rg], QU4); T1 = MFMA4F(QU2[rg] + EY[rg], PU[rg] + EY[rg], T1); }
#pragma unroll
        for (int rg = 0; rg < 4; ++rg) { QU8 = MFMA4F(PU4[rg], QU4[rg], QU8); T2 = MFMA4F(QU4[rg] + EY[rg], T1[rg], T2); }
#pragma unroll
        for (int rg = 0; rg < 4; ++rg) T3 = MFMA4F(QU8[rg] + EY[rg], T2[rg], T3);
        *(LAS f32x4v*)(DI + wave_s * 256 + lr * 16 + 4 * lq) = T3;
    }
    __syncthreads();
    {
        f32x4v xr[2][4];
#pragma unroll
        for (int B = 0; B < 4; ++B) {
            f32x4v pa[2], pb[2], dv[2];
#pragma unroll
            for (int pp = 0; pp < 2; ++pp) {
                const int pr = 2 * wave_s + pp, d = pr >> 3, e = 16 * (pr & 7) + lr;
                const LAS bf16_t* src = e < 64 ? vv + e : kk + (e - 64);
                const LAS float* sc = gs + 384 + d * 128 + (e < 64 ? 0 : 64);
#pragma unroll
                for (int rg = 0; rg < 4; ++rg) { const int rho = 16 * B + 4 * lq + rg, i = d ? 63 - rho : rho; pa[pp][rg] = sc[i] * bf2f(src[i * 72]); pb[pp][rg] = 0.f; }
                dv[pp] = *(const LAS f32x4v*)(DI + (d * 4 + B) * 256 + lr * 16 + 4 * lq);
            }
#pragma unroll
            for (int Bp = 0; Bp < B; ++Bp) {
                float av[2][4];
#pragma unroll
                for (int pp = 0; pp < 2; ++pp) {
                    const LAS float* Mn = ((2 * wave_s + pp) >> 3) ? M1 : M0;
#pragma unroll
                    for (int rg = 0; rg < 4; ++rg) av[pp][rg] = Mn[(16 * Bp + 4 * lq + rg) * MS + 16 * B + lr];
                }
#pragma unroll
                for (int rg = 0; rg < 4; rg += 2)
#pragma unroll
                    for (int pp = 0; pp < 2; ++pp) {
                        pa[pp] = MFMA4F(av[pp][rg], xr[pp][Bp][rg], pa[pp]);
                        pb[pp] = MFMA4F(av[pp][rg + 1], xr[pp][Bp][rg + 1], pb[pp]);
                    }
            }
            f32x4v xa[2], xb[2];
#pragma unroll
            for (int pp = 0; pp < 2; ++pp) { pa[pp] = pa[pp] + pb[pp]; xa[pp] = (f32x4v){0.f, 0.f, 0.f, 0.f}; xb[pp] = xa[pp]; }
#pragma unroll
            for (int rg = 0; rg < 4; rg += 2)
#pragma unroll
                for (int pp = 0; pp < 2; ++pp) {
                    xa[pp] = MFMA4F(dv[pp][rg], pa[pp][rg], xa[pp]);
                    xb[pp] = MFMA4F(dv[pp][rg + 1], pa[pp][rg + 1], xb[pp]);
                }
#pragma unroll
            for (int pp = 0; pp < 2; ++pp) xr[pp][B] = xa[pp] + xb[pp];
        }
#pragma unroll
        for (int pp = 0; pp < 2; ++pp) {
            const int pr = 2 * wave_s + pp, d = pr >> 3, e = 16 * (pr & 7) + lr;
            LAS float* X = xs + d * (64 * XS) + e;
#pragma unroll
            for (int B = 0; B < 4; ++B)
#pragma unroll
                for (int rg = 0; rg < 4; ++rg) X[(16 * B + 4 * lq + rg) * XS] = xr[pp][B][rg];
        }
    }
#undef MFMA4F
    __syncthreads();
    {
#pragma unroll
        for (int d = 0; d < 2; ++d) {
            const size_t recd = ((size_t)bh * 2 + d) * 68 + n;
            const LAS float* X = xs + d * (64 * XS);
            float o[8];
            {
                const u32x4 kw = *(const LAS u32x4*)(kT + r * 72 + 8 * (c ^ (r >> 3)));
                const float gl = gs[256 + d * 64 + (d ? 0 : 63)];
#pragma unroll
                for (int j = 0; j < 8; ++j) o[j] = ((j & 1) ? bfhi(kw[j >> 1]) : bflo(kw[j >> 1])) * __expf(gl - gs[256 + d * 64 + 8 * c + j]);
                *(u32x4*)(GKT_(p) + recd * 4096 + r * 64 + 8 * c) = pack8(o);
            }
#pragma unroll
            for (int j = 0; j < 8; ++j) { const int i = 8 * c + j, rho = d ? 63 - i : i; o[j] = X[rho * XS + r]; }
            *(u32x4*)(GUT_(p) + recd * 4096 + r * 64 + 8 * c) = pack8(o);
            { const int rho = d ? 63 - r : r;
#pragma unroll
              for (int j = 0; j < 8; ++j) o[j] = -X[rho * XS + 64 + 8 * c + j]; }
            *(u32x4*)(GWN_(p) + recd * 4096 + r * 64 + 8 * c) = pack8(o);
        }
        if (tid < 128) GGC_(p)[(size_t)task * 128 + tid] = gs[256 + tid] * 1.44269504088896f;
    }
    __syncthreads();
}

struct GdnOps { bf16x8 aw[2], ak[2]; u32x2 uw[2]; float gl; };
DEV void gdn_ops_load(GdnOps& o, const bf16_t* gwn, const bf16_t* gkt, const bf16_t* gut, const float* ggc, int chain, int step, int it, int jt0, int lr, int lq) {
    const int dir = chain & 1, n = chain_chunk(dir, step);
    const size_t recd = (size_t)chain * 68 + n;
#pragma unroll
    for (int ks = 0; ks < 2; ++ks) {
        o.aw[ks] = *(const bf16x8*)(gwn + recd * 4096 + (16 * it + lr) * 64 + 32 * ks + 8 * lq);
        o.ak[ks] = *(const bf16x8*)(gkt + recd * 4096 + (16 * it + lr) * 64 + 32 * ks + 8 * lq);
    }
#pragma unroll
    for (int t = 0; t < 2; ++t) o.uw[t] = *(const u32x2*)(gut + recd * 4096 + (16 * (jt0 + t) + lr) * 64 + 16 * it + 4 * lq);
    o.gl = ggc[((size_t)(chain >> 1) * 68 + n) * 128 + dir * 64 + (dir == 0 ? 63 : 0)];
}
DEV void gdn_scan_chain(const DParams& p, int chain, LAS unsigned char* lds, int tid, int wave_s) {
    const int lane = tid & 63, lr = lane & 15, lq = lane >> 4, it = wave_s >> 1, jt0 = 2 * (wave_s & 1);
    const int dir = chain & 1;
    LAS bf16_t* ST = (LAS bf16_t*)lds;
    bf16_t* gwn = GWN_(p); const bf16_t* gkt = GKT_(p); bf16_t* gut = GUT_(p); const float* ggc = GGC_(p);
    f32x4v S[2];
#pragma unroll
    for (int t = 0; t < 2; ++t) S[t] = (f32x4v){0.f, 0.f, 0.f, 0.f};
    GdnOps o0, o1, o2, o3;
    gdn_ops_load(o0, gwn, gkt, gut, ggc, chain, 0, it, jt0, lr, lq); gdn_ops_load(o1, gwn, gkt, gut, ggc, chain, 1, it, jt0, lr, lq);
    gdn_ops_load(o2, gwn, gkt, gut, ggc, chain, 2, it, jt0, lr, lq); gdn_ops_load(o3, gwn, gkt, gut, ggc, chain, 3, it, jt0, lr, lq);
#define GDN_STEP(O, STEP) do { \
        const size_t recd = (size_t)chain * 68 + chain_chunk(dir, (STEP)); \
        LAS bf16_t* STb = ST + ((STEP) & 1) * (2 * 64 * 72); LAS bf16_t* VNb = STb + 64 * 72;     \
        f32x4v vn[2]; \
        _Pragma("unroll") for (int t = 0; t < 2; ++t) { \
            vn[t] = (f32x4v){bflo(O.uw[t].x), bfhi(O.uw[t].x), bflo(O.uw[t].y), bfhi(O.uw[t].y)}; \
            u32x2 sw; sw.x = pkbf(S[t][0], S[t][1]); sw.y = pkbf(S[t][2], S[t][3]); \
            *(LAS u32x2*)(STb + (16 * (jt0 + t) + lr) * 72 + 16 * it + 4 * lq) = sw; } \
        LDS_BARRIER(); \
        bf16x8 sf[2][2]; \
        _Pragma("unroll") for (int t = 0; t < 2; ++t) _Pragma("unroll") for (int ks = 0; ks < 2; ++ks) sf[t][ks] = *(const LAS bf16x8*)(STb + (16 * (jt0 + t) + lr) * 72 + 32 * ks + 8 * lq); \
        _Pragma("unroll") for (int ks = 0; ks < 2; ++ks) _Pragma("unroll") for (int t = 0; t < 2; ++t) vn[t] = MFMA16(O.aw[ks], sf[t][ks], vn[t]); \
        _Pragma("unroll") for (int t = 0; t < 2; ++t) { \
            u32x2 w; w.x = pkbf(vn[t][0], vn[t][1]); w.y = pkbf(vn[t][2], vn[t][3]); \
            *(LAS u32x2*)(VNb + (16 * (jt0 + t) + lr) * 72 + 16 * it + 4 * lq) = w; } \
        LDS_BARRIER(); \
        const float gt = ex2(O.gl); \
        bf16x8 vf[2][2]; \
        _Pragma("unroll") for (int t = 0; t < 2; ++t) _Pragma("unroll") for (int ks = 0; ks < 2; ++ks) vf[t][ks] = *(const LAS bf16x8*)(VNb + (16 * (jt0 + t) + lr) * 72 + 32 * ks + 8 * lq); \
          \
        { const u32x4 c0 = *(const LAS u32x4*)(STb + (tid >> 3) * 72 + 8 * (tid & 7)), c1 = *(const LAS u32x4*)(VNb + (tid >> 3) * 72 + 8 * (tid & 7)); \
            *(u32x4*)(gwn + recd * 4096 + tid * 8) = c0; *(u32x4*)(gut + recd * 4096 + tid * 8) = c1; } \
        _Pragma("unroll") for (int t = 0; t < 2; ++t) S[t] = S[t] * gt; \
        _Pragma("unroll") for (int ks = 0; ks < 2; ++ks) _Pragma("unroll") for (int t = 0; t < 2; ++t) S[t] = MFMA16(O.ak[ks], vf[t][ks], S[t]); \
        if ((STEP) + 4 < 68) gdn_ops_load(O, gwn, gkt, gut, ggc, chain, (STEP) + 4, it, jt0, lr, lq); \
    } while (0)
#pragma unroll
    for (int step = 0; step < 68; step += 4) { GDN_STEP(o0, step); GDN_STEP(o1, step + 1); GDN_STEP(o2, step + 2); GDN_STEP(o3, step + 3); }
#undef GDN_STEP
    __syncthreads();
}

template <bool GDN>
DEV void la_out_task(const DParams& p, int layer, int task, int next_task, LAS unsigned char* lds, int gt, int gw) {
    const int n = task % 68, bh = task / 68, b = bh >> 2, h = bh & 3;
    const bool lat = n >= 4;
    const int row0 = chunk_row0(b, n);
    LAS bf16_t* q = (LAS bf16_t*)lds;
    LAS bf16_t* k = q + 64 * 72;
    LAS bf16_t* vT0 = k + 64 * 72;
    LAS bf16_t* vT1 = vT0 + 64 * 72;
    LAS bf16_t* ST0 = vT1 + 64 * 72;
    LAS bf16_t* ST1 = ST0 + 64 * 72;
    LAS bf16_t* A0 = ST1 + 64 * 72;
    LAS bf16_t* A1 = A0 + 64 * 72;
    LAS float* gcl = (LAS float*)(A1 + 64 * 72);
    const size_t s0 = ((size_t)bh * 2 + 0) * 68 + n, s1 = ((size_t)bh * 2 + 1) * 68 + n;
    const bf16_t* Pp = P_(p);
#pragma unroll
    for (int rep = 0; rep < 2; ++rep) {
        const int idx = gt + 256 * rep, r = idx >> 3, c = idx & 7;
        const bf16_t* prow = Pp + (size_t)(row0 + r) * PST;
        float o[8];
        if (GDN) {
            const float* cw = lp(p.gdn_conv_w) + (size_t)layer * 3 * 768;
            const int slen = n < 4 ? CTX : SQ, t0 = n < 4 ? n * 64 : (n - 4) * 64;
            const bool hasp = t0 + r > 0, hasn = t0 + r + 1 < slen;
            gdn_conv8(cw, prow + C_GQ + h * 64 + 8 * c, h * 64 + 8 * c, hasp, hasn, o);
            l2norm8(o, 0.125f);
            *(LAS u32x4*)(q + r * 72 + 8 * c) = pack8(o);
            gdn_conv8(cw, prow + C_GK + h * 64 + 8 * c, 256 + h * 64 + 8 * c, hasp, hasn, o);
            l2norm8(o, 1.0f);
            *(LAS u32x4*)(k + r * 72 + 8 * c) = pack8(o);
            *(LAS u32x4*)(vT0 + r * 72 + 8 * c) = *(const u32x4*)(GUT_(p) + s0 * 4096 + r * 64 + 8 * c);
            *(LAS u32x4*)(vT1 + r * 72 + 8 * c) = *(const u32x4*)(GUT_(p) + s1 * 4096 + r * 64 + 8 * c);
            *(LAS u32x4*)(ST0 + r * 72 + 8 * c) = *(const u32x4*)(GWN_(p) + s0 * 4096 + r * 64 + 8 * c);
            *(LAS u32x4*)(ST1 + r * 72 + 8 * c) = *(const u32x4*)(GWN_(p) + s1 * 4096 + r * 64 + 8 * c);
        } else {
            load_rope8(p, prow + C_RQ + h * 64, c, lat, (n - 4) * 64 + r, 1.0f, o);
            *(LAS u32x4*)(q + r * 72 + 8 * c) = pack8(o);
            load_rope8(p, prow + C_RK + h * 64, c, lat, (n - 4) * 64 + r, 0.125f, o);
            *(LAS u32x4*)(k + r * 72 + 8 * c) = pack8(o);
            const u32x4 vw = *(const u32x4*)(RVT_(p) + (size_t)task * 4096 + r * 64 + 8 * c);
            *(LAS u32x4*)(vT0 + r * 72 + 8 * c) = vw;
            *(LAS u32x4*)(vT1 + r * 72 + 8 * c) = vw;
            *(LAS u32x4*)(ST0 + r * 72 + 8 * c) = *(const u32x4*)(RST_(p) + s0 * 4096 + r * 64 + 8 * c);
            *(LAS u32x4*)(ST1 + r * 72 + 8 * c) = *(const u32x4*)(RST_(p) + s1 * 4096 + r * 64 + 8 * c);
        }
    }
    if (gt < 128) {
        if (GDN) gcl[gt] = GGC_(p)[(size_t)task * 128 + gt];
        else { const int d = gt >> 6, i = gt & 63; gcl[gt] = ret_lg2(p, layer, d, h) * (float)(d == 0 ? i + 1 : 64 - i); }
    }
    const int lane = gt & 63, lr = lane & 15, lq = lane >> 4;
    const int gcol = (GDN ? C_GZ : C_RG) + h * 64, mcol = (GDN ? 768 : 0) + h * 64;
    const int tokr = row0 + 16 * gw + lr;
    u32x2 gz[4];
#pragma unroll
    for (int t = 0; t < 4; ++t) gz[t] = *(const u32x2*)(Pp + (size_t)tokr * PST + gcol + 16 * t + 4 * lq);
    __syncthreads();
    unsigned pf0 = 0u, pf1 = 0u, pf2 = 0u;
    if (next_task >= 0) {
        const int n2 = next_task % 68, bh2 = next_task / 68, b2 = bh2 >> 2, h2 = bh2 & 3;
        const size_t s02 = ((size_t)bh2 * 2 + 0) * 68 + n2, s12 = ((size_t)bh2 * 2 + 1) * 68 + n2;
        const int tl = gt >> 6, ln = gt & 63;
        const bf16_t* tb = GDN ? (tl == 0 ? GUT_(p) + s02 * 4096 : tl == 1 ? GUT_(p) + s12 * 4096 : tl == 2 ? GWN_(p) + s02 * 4096 : GWN_(p) + s12 * 4096)
                               : (tl == 0 ? RVT_(p) + (size_t)next_task * 4096 : tl == 1 ? RST_(p) + s02 * 4096 : RST_(p) + s12 * 4096);
        if (GDN || tl < 3) pf0 = *(const unsigned*)(tb + ln * 64);
        const bf16_t* pr2 = Pp + (size_t)(chunk_row0(b2, n2) + (gt >> 2)) * PST + h2 * 64;
        const int kd = gt & 3, cq = GDN ? C_GQ : C_RQ, ck = GDN ? C_GK : C_RK, cg = GDN ? C_GZ : C_RG;
        pf1 = *(const unsigned*)(pr2 + (kd == 0 ? cq : kd == 1 ? ck : kd == 2 ? cg : cq + 62));
        if (kd < 2) pf2 = *(const unsigned*)(pr2 + (kd == 0 ? ck + 62 : cg + 62));
    }
    asm volatile("" ::: "memory");
    {
        bf16x8 bq[2];
#pragma unroll
        for (int ks = 0; ks < 2; ++ks) bq[ks] = *(const LAS bf16x8*)(q + (16 * gw + lr) * 72 + 32 * ks + 8 * lq);
        const int i = 16 * gw + lr;
        const float gi0 = gcl[i], gi1 = gcl[64 + i];
#pragma unroll
        for (int jt = 0; jt < 4; ++jt) {
            f32x4v acc = (f32x4v){0.f, 0.f, 0.f, 0.f};
#pragma unroll
            for (int ks = 0; ks < 2; ++ks) acc = MFMA16(*(const LAS bf16x8*)(k + (16 * jt + lr) * 72 + 32 * ks + 8 * lq), bq[ks], acc);
            float f[4], g[4];
#pragma unroll
            for (int rg = 0; rg < 4; ++rg) {
                const int j = 16 * jt + 4 * lq + rg;
                f[rg] = i >= j ? acc[rg] * ex2(gi0 - gcl[j]) : 0.f;
                g[rg] = i <= j ? acc[rg] * ex2(gi1 - gcl[64 + j]) : 0.f;
            }
            u32x2 w0, w1; w0.x = pkbf(f[0], f[1]); w0.y = pkbf(f[2], f[3]); w1.x = pkbf(g[0], g[1]); w1.y = pkbf(g[2], g[3]);
            *(LAS u32x2*)(A0 + i * 72 + 16 * jt + 4 * lq) = w0;
            *(LAS u32x2*)(A1 + i * 72 + 16 * jt + 4 * lq) = w1;
        }
    }
    asm volatile("s_waitcnt lgkmcnt(0)" ::: "memory");
    f32x4v o[4];
#pragma unroll
    for (int t = 0; t < 4; ++t) o[t] = (f32x4v){0.f, 0.f, 0.f, 0.f};
#pragma unroll
    for (int d = 0; d < 2; ++d) {
        const LAS bf16_t* ST = d == 0 ? ST0 : ST1;
        const LAS bf16_t* AT = d == 0 ? A0 : A1;
        const LAS bf16_t* VT = d == 0 ? vT0 : vT1;
        bf16x8 bq[2], ba[2];
#pragma unroll
        for (int ks = 0; ks < 2; ++ks) {
            bq[ks] = *(const LAS bf16x8*)(q + (16 * gw + lr) * 72 + 32 * ks + 8 * lq);
            ba[ks] = *(const LAS bf16x8*)(AT + (16 * gw + lr) * 72 + 32 * ks + 8 * lq);
        }
        const float rsc = ex2(gcl[d * 64 + 16 * gw + lr]);
#pragma unroll
        for (int t = 0; t < 4; ++t) {
            f32x4v acc = (f32x4v){0.f, 0.f, 0.f, 0.f};
#pragma unroll
            for (int ks = 0; ks < 2; ++ks) acc = MFMA16(*(const LAS bf16x8*)(ST + (16 * t + lr) * 72 + 32 * ks + 8 * lq), bq[ks], acc);
            acc = acc * rsc;
#pragma unroll
            for (int ks = 0; ks < 2; ++ks) acc = MFMA16(*(const LAS bf16x8*)(VT + (16 * t + lr) * 72 + 32 * ks + 8 * lq), ba[ks], acc);
            o[t] = o[t] + acc;
        }
    }
    {
        const float* nw = GDN ? lp(p.gdn_norm_w) + (size_t)layer * 64 : lp(p.ret_norm_w) + (size_t)layer * 256 + h * 64;
        float ss = 0.f;
#pragma unroll
        for (int t = 0; t < 4; ++t) ss += (o[t][0] * o[t][0] + o[t][1] * o[t][1]) + (o[t][2] * o[t][2] + o[t][3] * o[t][3]);
        ss += shfl_xor_l(ss, 16); ss += shfl_xor_l(ss, 32);
        const float rs = __builtin_amdgcn_rsqf(ss * (1.0f / 64.0f) + 1e-6f);
        bf16_t* mp = H_(p) + (size_t)tokr * 1024 + mcol + 4 * lq;
#pragma unroll
        for (int t = 0; t < 4; ++t) {
            const f32x4v w4 = *(const f32x4v*)(nw + 16 * t + 4 * lq);
            const float g0 = bflo(gz[t].x), g1 = bfhi(gz[t].x), g2 = bflo(gz[t].y), g3 = bfhi(gz[t].y);
            u32x2 w; w.x = pkbf(o[t][0] * rs * w4[0] * siluf(g0), o[t][1] * rs * w4[1] * siluf(g1)); w.y = pkbf(o[t][2] * rs * w4[2] * siluf(g2), o[t][3] * rs * w4[3] * siluf(g3));
            *(u32x2*)(mp + 16 * t) = w;
        }
    }
    asm volatile("" :: "v"(pf0), "v"(pf1), "v"(pf2));
    __syncthreads();
}


DEV void mix_prep_item(const DParams& p, int item2, LAS unsigned char* lds, int tid) {
    const int item = item2 >> 1, half = item2 & 1;
    const int b = item / 68, n = item % 68;
    const bool lat = n >= 4;
    const int row0 = chunk_row0(b, n), r = tid >> 3, c = tid & 7, t = (n - 4) * 64 + r;
    const bf16_t* prow = P_(p) + (size_t)(row0 + r) * PST;
    bf16_t* rktb = RKT_(p); bf16_t* rvtb = RVT_(p); bf16_t* ktb = KT_(p); bf16_t* vtb = VT_(p);
    u32x4 kx[3], kp[3], vx[3];
#pragma unroll
    for (int q = 0; q < 3; ++q) {
        const int kc = q < 2 ? C_RK + (2 * half + q) * 64 : C_SK + half * 64, vc = q < 2 ? C_RV + (2 * half + q) * 64 : C_SV + half * 64;
        kx[q] = *(const u32x4*)(prow + kc + 8 * c);
        kp[q] = lat ? *(const u32x4*)(prow + kc + 8 * (c ^ 2)) : kx[q];
        vx[q] = *(const u32x4*)(prow + vc + 8 * c);
    }
    f32x4 rt[4];
    {
        const int pos = lat ? ((c >> 2) == 0 ? t / 64 : t % 64) : 0;
        const float* rp = ROPE_(p) + (pos * 16 + 8 * (c & 1)) * 2;
#pragma unroll
        for (int q4 = 0; q4 < 4; ++q4) rt[q4] = *(const f32x4*)(rp + 4 * q4);
    }
    LAS bf16_t* tiles = (LAS bf16_t*)lds;
    const bool first = (c & 2) == 0;
    const int posk = kswz(r);
#pragma unroll
    for (int q = 0; q < 3; ++q) {
        float o[8];
#pragma unroll
        for (int j = 0; j < 8; ++j) {
            const float mine = (j & 1) ? bfhi(kx[q][j >> 1]) : bflo(kx[q][j >> 1]);
            if (lat) {
                const float oth = (j & 1) ? bfhi(kp[q][j >> 1]) : bflo(kp[q][j >> 1]);
                const float cs = rt[j >> 1][2 * (j & 1)], sn = rt[j >> 1][2 * (j & 1) + 1];
                o[j] = first ? mine * cs - oth * sn : oth * sn + mine * cs;
            } else o[j] = mine;
        }
        if (q < 2) {
            LAS bf16_t* kt = tiles + q * (64 * 72);
            LAS bf16_t* vt = tiles + (2 + q) * (64 * 72);
#pragma unroll
            for (int j = 0; j < 8; ++j) {
                kt[(8 * c + j) * 72 + (r ^ (8 * c))] = f2bf(o[j] * 0.125f);
                vt[(8 * c + j) * 72 + (r ^ (8 * c))] = (bf16_t)((vx[q][j >> 1] >> (16 * (j & 1))) & 0xffffu);
            }
        } else {
            const size_t rec = (size_t)(b * 2 + half) * 68 + n;
            *(u32x4*)(ktb + rec * 4096 + r * 64 + ((c ^ ((r >> 1) & 7)) * 8)) = pack8(o);
            LAS bf16_t* vt = tiles + 4 * (64 * 72);
#pragma unroll
            for (int j = 0; j < 8; ++j) vt[(8 * c + j) * 72 + (posk ^ (8 * c))] = (bf16_t)((vx[q][j >> 1] >> (16 * (j & 1))) & 0xffffu);
        }
    }
    __syncthreads();
#pragma unroll
    for (int q = 0; q < 2; ++q) {
        const size_t rec = (size_t)(b * 4 + 2 * half + q) * 68 + n;
        *(u32x4*)(rktb + rec * 4096 + r * 64 + 8 * c) = *(const LAS u32x4*)(tiles + q * (64 * 72) + r * 72 + 8 * (c ^ (r >> 3)));
        *(u32x4*)(rvtb + rec * 4096 + r * 64 + 8 * c) = *(const LAS u32x4*)(tiles + (2 + q) * (64 * 72) + r * 72 + 8 * (c ^ (r >> 3)));
    }
    {
        const size_t rec = (size_t)(b * 2 + half) * 68 + n;
        *(u32x4*)(vtb + rec * 4096 + r * 64 + ((c ^ ((r >> 1) & 7)) * 8)) = *(const LAS u32x4*)(tiles + 4 * (64 * 72) + r * 72 + 8 * (c ^ (r >> 3)));
    }
    __syncthreads();
}


DEV void ctx_res_tile(const DParams& p, int tile, const bf16_t* A, int lda, const bf16_t* Wt, int K, const float* xsrc, const float* modl, int gidx, const float* nwsc, bf16_t* An,
                      LAS unsigned char* lds, int tid, int wave_s) {
    const int rb = tile >> 3, cb = tile & 7, lane = tid & 63, lr = lane & 15, lq = lane >> 4, rt = wave_s & 3, ch = wave_s >> 2;
    const int nk = K / 64;
    const int ar = tid >> 3, ac = tid & 7;
    const bf16_t* ag = A + (size_t)(64 * rb + ar) * lda + 8 * ac;
    const bf16_t* bg0 = Wt + (size_t)(128 * cb + ar) * K + 8 * ac;
    const bf16_t* bg1 = bg0 + (size_t)64 * K;
    LAS bf16_t* buf = (LAS bf16_t*)lds;
    f32x4v acc[4];
#pragma unroll
    for (int j = 0; j < 4; ++j) acc[j] = (f32x4v){0.f, 0.f, 0.f, 0.f};
    u32x4 ra0, rb00, rb10, ra1 = (u32x4){0u, 0u, 0u, 0u}, rb01 = ra1, rb11 = ra1;
#define CT_LOAD(S, KT) do { ra##S = *(const u32x4*)(ag + 64 * (KT)); rb0##S = *(const u32x4*)(bg0 + 64 * (KT)); rb1##S = *(const u32x4*)(bg1 + 64 * (KT)); } while (0)
#define CT_STORE(S, BP) do { *(LAS u32x4*)((BP) + ar * 72 + 8 * ac) = ra##S; *(LAS u32x4*)((BP) + 64 * 72 + ar * 72 + 8 * ac) = rb0##S; *(LAS u32x4*)((BP) + 64 * 72 + (ar + 64) * 72 + 8 * ac) = rb1##S; } while (0)
#define CT_COMPUTE(CUR) do { bf16x8 af[2], bfr[4][2]; \
        _Pragma("unroll") for (int ks = 0; ks < 2; ++ks) { af[ks] = *(const LAS bf16x8*)((CUR) + (16 * rt + lr) * 72 + 32 * ks + 8 * lq); \
            _Pragma("unroll") for (int j = 0; j < 4; ++j) bfr[j][ks] = *(const LAS bf16x8*)((CUR) + 64 * 72 + (64 * ch + 16 * j + lr) * 72 + 32 * ks + 8 * lq); } \
        _Pragma("unroll") for (int ks = 0; ks < 2; ++ks) _Pragma("unroll") for (int j = 0; j < 4; ++j) acc[j] = MFMA16(af[ks], bfr[j][ks], acc[j]); } while (0)
    LAS bf16_t* buf0 = buf; LAS bf16_t* buf1 = buf + 192 * 72;
    CT_LOAD(0, 0);
    CT_STORE(0, buf0);
    if (nk > 1) CT_LOAD(1, 1);
    if (nk > 2) CT_LOAD(0, 2);
    LDS_BARRIER();
    for (int kt = 0; kt < nk; kt += 2) {
        if (kt + 1 < nk) CT_STORE(1, buf1);
        if (kt + 3 < nk) CT_LOAD(1, kt + 3);
        CT_COMPUTE(buf0);
        LDS_BARRIER();
        if (kt + 1 < nk) {
            if (kt + 2 < nk) CT_STORE(0, buf0);
            if (kt + 4 < nk) CT_LOAD(0, kt + 4);
            CT_COMPUTE(buf1);
            LDS_BARRIER();
        }
    }
#undef CT_LOAD
#undef CT_STORE
#undef CT_COMPUTE
    const int c0 = 128 * cb + 64 * ch + lr;
    float gv[4], nv[4];
#pragma unroll
    for (int j = 0; j < 4; ++j) { gv[j] = modl[(size_t)NB * NMOD * DM + gidx * DM + c0 + 16 * j]; nv[j] = nwsc[(size_t)NB * DM + c0 + 16 * j]; }
#pragma unroll
    for (int rg = 0; rg < 4; ++rg) {
        const int R = 64 * rb + 16 * rt + 4 * lq + rg;
        float xo[4];
#pragma unroll
        for (int j = 0; j < 4; ++j) xo[j] = xsrc[(size_t)R * DM + c0 + 16 * j];
        float sq = 0.f;
#pragma unroll
        for (int j = 0; j < 4; ++j) {
            const float xn = xo[j] + gv[j] * acc[j][rg];
            XC_(p)[(size_t)R * DM + c0 + 16 * j] = xn;
            An[(size_t)R * DM + c0 + 16 * j] = f2bf(xn * nv[j]);
            sq += xn * xn;
        }
        sq = row16_sum(sq);
        if (lr == 0) SSQ_(p)[(size_t)R * 16 + cb * 2 + ch] = sq;
    }
    __syncthreads();
}

DEV void gate_cols(const DParams& p, int layer, LAS unsigned char* lds, int tid, int wave_s) {
    const int lane = tid & 63, lr = lane & 15, lq = lane >> 4;
    LAS float* part = (LAS float*)lds;
    const bf16_t* Wt = WIN_(p) + (size_t)layer * NPAD * DM + (size_t)(C_GA + lr) * DM + 128 * wave_s + 8 * lq;
    for (int rgp = blockIdx.x; rgp < 256; rgp += gridDim.x) {
        const int R0 = rgp * (ROWS / 256);
        bf16x8 bfr[4], afr[9][4];
#pragma unroll
        for (int ks = 0; ks < 4; ++ks) bfr[ks] = *(const bf16x8*)(Wt + 32 * ks);
#pragma unroll
        for (int t = 0; t < 9; ++t) {
            const int rl = 16 * t + lr, rc = rl < ROWS / 256 ? rl : ROWS / 256 - 1;
            const bf16_t* ap = H_(p) + (size_t)(R0 + rc) * DM + 128 * wave_s + 8 * lq;
#pragma unroll
            for (int ks = 0; ks < 4; ++ks) afr[t][ks] = *(const bf16x8*)(ap + 32 * ks);
        }
        const int orow = tid >> 1, oc = 8 * (tid & 1), R = R0 + (orow < ROWS / 256 ? orow : 0);
        const f32x4* sp = (const f32x4*)(SSQ_(p) + (size_t)R * 16);
        const f32x4 s0 = sp[0], s1 = sp[1], s2 = sp[2], s3 = sp[3];
        const float* bp = BIAS_(p) + ((size_t)(layer * 2 + 0) * 9 + modrow(R)) * 5632 + C_GA + oc;
        const f32x4 b0 = *(const f32x4*)bp, b1 = *(const f32x4*)(bp + 4);
#pragma unroll
        for (int t = 0; t < 9; ++t) {
            f32x4v acc = (f32x4v){0.f, 0.f, 0.f, 0.f};
#pragma unroll
            for (int ks = 0; ks < 4; ++ks) acc = MFMA16(afr[t][ks], bfr[ks], acc);
#pragma unroll
            for (int rg = 0; rg < 4; ++rg) part[(wave_s * 9 + t) * 256 + (4 * lq + rg) * 16 + lr] = acc[rg];
        }
        __syncthreads();
        if (orow < ROWS / 256) {
            f32x4 a0 = (f32x4){0.f, 0.f, 0.f, 0.f}, a1 = a0;
#pragma unroll
            for (int w8 = 0; w8 < 8; ++w8) {
                const LAS f32x4* pp = (const LAS f32x4*)(part + (w8 * 9 + (orow >> 4)) * 256 + (orow & 15) * 16 + oc);
                a0 = a0 + pp[0]; a1 = a1 + pp[1];
            }
            const float ss = ((s0.x + s0.y) + (s0.z + s0.w)) + ((s1.x + s1.y) + (s1.z + s1.w)) + ((s2.x + s2.y) + (s2.z + s2.w)) + ((s3.x + s3.y) + (s3.z + s3.w));
            const float rs = __builtin_amdgcn_rsqf(ss * (1.0f / DM) + 1e-6f);
            a0 = a0 * rs + b0; a1 = a1 * rs + b1;
            u32x4 w; w.x = pg8::cvt_pk_bf16(a0.x, a0.y); w.y = pg8::cvt_pk_bf16(a0.z, a0.w); w.z = pg8::cvt_pk_bf16(a1.x, a1.y); w.w = pg8::cvt_pk_bf16(a1.z, a1.w);
            *(u32x4*)(P_(p) + (size_t)R * PST + C_GA + oc) = w;
        }
        __syncthreads();
    }
}

DEV void ph_m1(const DParams& p, int layer, LAS unsigned char* lds, int wave_s) {
    wave_s = launder_s(wave_s);
    const int tid = get_tid(wave_s);
    {
        GdnPre pre;
        int t = blockIdx.x;
        if (t < NB * 4 * 68) gdn_pre_load(pre, p, t, tid);
        for (; t < NB * 4 * 68; t += gridDim.x) {
            const int nt = t + (int)gridDim.x;
            gdn_prep_task(p, layer, t, nt < NB * 4 * 68 ? nt : -1, pre, lds, tid, wave_s);
        }
    }
    for (int t = (int)gridDim.x - 1 - (int)blockIdx.x; t < 2 * NB * 68; t += gridDim.x) mix_prep_item(p, t, lds, tid);
}
DEV void ph_m2(const DParams& p, int layer, bool need_ctx, LAS unsigned char* lds, int wave_s) {
    wave_s = launder_s(wave_s);
    const int tid = get_tid(wave_s);
    const int rb = (int)gridDim.x - 1 - (int)blockIdx.x;
    for (int ch = rb; ch < NB * 4 * 2; ch += gridDim.x) gdn_scan_chain(p, ch, lds, tid, wave_s);
    for (int ch = rb - NB * 4 * 2; ch < NB * 4 * 2; ch += gridDim.x) if (ch >= 0) ret_scan_chain(p, layer, ch, tid, wave_s);
    const int nunits = NB * 2 * 64 + (need_ctx ? NB * 2 * 4 : 0);
    unsigned* ctr = (unsigned*)(lp(p.ws) + O_CTR) + layer * 16;
    volatile LAS unsigned* slot = (volatile LAS unsigned*)(lds + LDS_BYTES - 32);
    for (;;) {
        if (tid == 0) slot[0] = atomicAdd(ctr, 1u);
        __syncthreads();
        const int u = (int)slot[0];
        __syncthreads();
        if (u >= nunits) break;
        swa_unit(p, layer, u, lds, tid, wave_s);
    }
}
DEV void ph_m3(const DParams& p, int layer, bool need_ctx, LAS unsigned char* lds, int wave_s) {
    wave_s = launder_s(wave_s);
    const int tid = get_tid(wave_s), gt = tid & 255, gw = wave_s & 3;
    const int nch = need_ctx ? 68 : 64, ntask = NB * 4 * nch;
    for (int t = blockIdx.x; t < ntask; t += gridDim.x) {
        const int tk = (t / nch) * 68 + (68 - nch) + (t % nch);
        const int t2 = t + (int)gridDim.x, tk2 = t2 < ntask ? (t2 / nch) * 68 + (68 - nch) + (t2 % nch) : -1;
        const int gwl = launder_s(gw);
        if (wave_s < 4) la_out_task<false>(p, layer, tk, tk2, lds, gt, gwl);
        else la_out_task<true>(p, layer, tk, tk2, lds + 74240, gt, gwl);
    }
}
DEV void ph_final(const DParams& p, int wave_s) {
    wave_s = launder_s(wave_s);
    const int tid_ = get_tid(wave_s), lane = tid_ & 63, gw = blockIdx.x * NW + (tid_ >> 6), ngw = gridDim.x * NW;
    for (int r = gw; r < NB * SQ; r += ngw) {
        f32x4* xr = (f32x4*)(lp(p.XL) + (size_t)r * DM) + lane;
        f32x4 v[4]; float s = 0.f;
#pragma unroll
        for (int j = 0; j < 4; ++j) { v[j] = xr[64 * j]; s += (v[j].x * v[j].x + v[j].y * v[j].y) + (v[j].z * v[j].z + v[j].w * v[j].w); }
        const float rs = 1.0f / sqrtf(wave_sum(s) * (1.0f / DM) + 1e-6f);
        const f32x4* w4 = (const f32x4*)lp(p.final_norm_w) + lane;
#pragma unroll
        for (int j = 0; j < 4; ++j) xr[64 * j] = v[j] * rs * w4[64 * j];
    }
}

__global__ void __launch_bounds__(NT, 2) mega(Params kargs) {
    extern __shared__ __attribute__((aligned(16))) unsigned char lds_raw[];
    LAS unsigned char* lds = (LAS unsigned char*)lds_raw;
    const int wave_s = __builtin_amdgcn_readfirstlane(threadIdx.x >> 6);
    volatile LAS unsigned* bst = (volatile LAS unsigned*)(lds + LDS_BYTES - 16);
    if (threadIdx.x == 0) { bst[0] = 0u; bst[1] = 0u; }
    __syncthreads();
    const XcdBarrier bar = xcd_barrier_post((unsigned*)(kargs.ws + O_BAR), bst, (int)threadIdx.x);
    cg::this_grid().sync();
#define GSYNC() xcd_barrier(bar, get_tid(wave_s))
    const int G = gridDim.x, bid = blockIdx.x;
    { const DParams p = load_params(); ph_prologue(p, lds, wave_s); }
    GSYNC();
    { const DParams p = load_params(); ph_pre0(p, lds, wave_s); }
    GSYNC();
    for (int layer = 0; layer < 2; ++layer) {
        const bool need_ctx = layer == 0;
        const int rlo = need_ctx ? 0 : NCR, M2 = ROWS - rlo;
        {
            const DParams p = load_params();
            pg8::Gemm g{H_(p), WIN_(p) + (size_t)layer * NPAD * DM, ROWS, C_GA, DM}; pg8::StaticOrder S; S.init(ROWS, C_GA, G, bid);
            EpiP E{P_(p), PST, SSQ_(p), BIAS_(p) + (size_t)(layer * 2 + 0) * 9 * 5632};
            pg8::gemm_phase<EpiP, pg8::StaticOrder, false>(lds, g, S, E, nullptr, wave_s);
            { const int wl = launder_s(wave_s); gate_cols(p, layer, lds, get_tid(wl), wl); }
        }
        GSYNC();
        { const DParams p = load_params(); ph_m1(p, layer, lds, wave_s); }
        GSYNC();
        { const DParams p = load_params(); ph_m2(p, layer, need_ctx, lds, wave_s); }
        GSYNC();
        { const DParams p = load_params(); ph_m3(p, layer, need_ctx, lds, wave_s); }
        GSYNC();
        {
            const DParams p = load_params(); const float* modl = MOD_(p) + (size_t)layer * (NB + 1) * NMOD * DM;
            pg8::Gemm g{H_(p) + (size_t)NCR * 1024, WOUT_(p) + (size_t)layer * DM * 1024, ROWS - NCR, DM, 1024}; pg8::StaticOrder S; S.init(ROWS - NCR, DM, G, bid);
            EpiRes E{layer == 0 ? lp(p.x) : (const float*)lp(p.XL), XC_(p), lp(p.XL), XC_(p), modl, 2, NCR,
                     NWSC_(p) + (size_t)(layer * 2 + 1) * 9 * DM, A2_(p), SSQ_(p)};
            pg8::gemm_phase<EpiRes, pg8::StaticOrder, false>(lds, g, S, E, nullptr, wave_s);
            if (layer == 0) { const int wl = launder_s(wave_s), tid = get_tid(wl);
                for (int t = bid; t < 256; t += G) ctx_res_tile(p, t, H_(p), 1024, WOUT_(p), 1024, lp(p.ctx), modl, 2, NWSC_(p) + (size_t)(0 * 2 + 1) * 9 * DM, A2_(p), lds, tid, wl); }
        }
        GSYNC();
        {
            const DParams p = load_params();
            pg8::Gemm g{A2_(p) + (size_t)rlo * 1024, WF1_(p) + (size_t)layer * 2 * DFF * DM, M2, 2 * DFF, DM}; pg8::StaticOrder S; S.init(M2, 2 * DFF, G, bid);
            EpiSwiglu E{P_(p) + (size_t)rlo * DFF, DFF, SSQ_(p), BIAS_(p) + (size_t)(layer * 2 + 1) * 9 * 5632, rlo};
            pg8::gemm_phase<EpiSwiglu, pg8::StaticOrder, false>(lds, g, S, E, nullptr, wave_s);
        }
        GSYNC();
        {
            const DParams p = load_params(); const float* modl = MOD_(p) + (size_t)layer * (NB + 1) * NMOD * DM;
            pg8::Gemm g{P_(p) + (size_t)NCR * DFF, WF2_(p) + (size_t)layer * DM * DFF, ROWS - NCR, DM, DFF}; pg8::StaticOrder S; S.init(ROWS - NCR, DM, G, bid);
            EpiRes E{lp(p.XL), XC_(p), lp(p.XL), XC_(p), modl, 5, NCR, layer == 0 ? NWSC_(p) + (size_t)(1 * 2 + 0) * 9 * DM : (const float*)nullptr, H_(p), SSQ_(p)};
            pg8::gemm_phase<EpiRes, pg8::StaticOrder, false>(lds, g, S, E, nullptr, wave_s);
            if (layer == 0) { const int wl = launder_s(wave_s), tid = get_tid(wl);
                for (int t = bid; t < 256; t += G) ctx_res_tile(p, t, P_(p), DFF, WF2_(p), DFF, XC_(p), modl, 5, NWSC_(p) + (size_t)(1 * 2 + 0) * 9 * DM, H_(p), lds, tid, wl); }
        }
        GSYNC();
    }
    { const DParams p = load_params(); ph_final(p, wave_s); }
}

extern "C" void kernel_launch(void* const* d_in, const int* in_sizes, int n_in, void* d_out, int out_size, void* d_ws, size_t ws_size,
                              hipStream_t stream) {
    static int grid_blocks = 0;
    if (!grid_blocks) {
        int dev = 0, cus = 0, per_cu = 0;
        (void)hipGetDevice(&dev);
        (void)hipDeviceGetAttribute(&cus, hipDeviceAttributeMultiprocessorCount, dev);
        (void)hipFuncSetAttribute((const void*)mega, hipFuncAttributeMaxDynamicSharedMemorySize, LDS_BYTES);
        (void)hipOccupancyMaxActiveBlocksPerMultiprocessor(&per_cu, (const void*)mega, NT, LDS_BYTES);
        if (per_cu < 1) { fprintf(stderr, "occupancy query says %d blocks/CU\n", per_cu); per_cu = 1; }
        grid_blocks = cus;
    }
    Params p{};
    const float** ip = (const float**)&p;
    for (int i = 0; i < 20; ++i) ip[i] = (const float*)d_in[i];
    p.XL = (float*)d_out;
    p.ws = (char*)d_ws;
    if (WS_END > ws_size) { fprintf(stderr, "ws too small: need %zu have %zu\n", (size_t)WS_END, ws_size); return; }
    (void)hipMemsetAsync((char*)d_ws + O_BAR, 0, BAR_BYTES, stream);
    void* args[] = {&p};
    hipError_t e = hipLaunchCooperativeKernel((void*)mega, dim3(grid_blocks), dim3(NT), args, LDS_BYTES, stream);
    if (e != hipSuccess) fprintf(stderr, "cooperative launch failed: %s (grid %d)\n", hipGetErrorString(e), grid_blocks);
}
```
